# Optimizing an MI355X kernel written in HIP

```python
import math
import jax
import jax.numpy as jnp
from jax import lax
import numpy as np

D_MODEL = 1024
BATCH = 8
SEQ = 4096
DEPTH = 2

GRID_W = 64
CTX_LEN = 256
HEAD_DIM = 64
ROPE_THETA = 10000.0
NORM_EPS = 1e-6
Q_BLOCK = 128
NEG_INF = -1e30
N_MOD = 6

HALF_WIDTH = D_MODEL // 2

A_HEADS = HALF_WIDTH // HEAD_DIM
A_KV_HEADS = 2
A_GROUP = A_HEADS // A_KV_HEADS
A_SCALE = HEAD_DIM ** -0.5

B_NOPE = 64
B_ROPE = 32
B_VDIM = 64
B_HEADS = HALF_WIDTH // B_VDIM
B_Q_RANK = 384
B_KV_RANK = 256
B_SCALE = (B_NOPE + B_ROPE) ** -0.5

C_WIDTH = HALF_WIDTH
C_EMB_DIM = 5
C_BANDS = (C_EMB_DIM - 1) // 2
C_FILTER_WIDTH = 64
C_MIN_DECAY = math.log(1e-2) / 1.5
C_MAX_DECAY = math.log(1e-2) / 0.3

D_HEADS = HALF_WIDTH // HEAD_DIM
D_KV_HEADS = 2
D_GROUP = D_HEADS // D_KV_HEADS
D_SCALE = HEAD_DIM ** -0.5
WINDOW = 128

FFN_DIM = 2816

EV_SIZES = (A_HEADS * HEAD_DIM, B_Q_RANK, A_KV_HEADS * HEAD_DIM, A_KV_HEADS * HEAD_DIM, B_KV_RANK, B_ROPE)
EV_Q_COLS = A_HEADS * HEAD_DIM + B_Q_RANK
EV_COLS = EV_Q_COLS + 2 * A_KV_HEADS * HEAD_DIM + B_KV_RANK + B_ROPE
EV_OUT = A_HEADS * HEAD_DIM + B_HEADS * B_VDIM
OD_SIZES = (D_HEADS * HEAD_DIM, 3 * C_WIDTH, D_KV_HEADS * HEAD_DIM, D_KV_HEADS * HEAD_DIM)
OD_Q_COLS = D_HEADS * HEAD_DIM + 3 * C_WIDTH
OD_COLS = OD_Q_COLS + 2 * D_KV_HEADS * HEAD_DIM
OD_OUT = D_HEADS * HEAD_DIM + C_WIDTH

kernel_name = "hybrid_dit_prefix_trunk"


def _split(z, sizes):
    out, start = [], 0
    for s in sizes:
        out.append(z[..., start:start + s])
        start += s
    return out


def _rmsnorm(x, gain):
    xf = x.astype(jnp.float32)
    inv = lax.rsqrt(jnp.mean(xf * xf, axis=-1, keepdims=True) + NORM_EPS)
    return (xf * inv).astype(x.dtype) * gain


def _modulate(h, shift, scale):
    return h * (1 + scale) + shift


def _axial_rope(rows, rope_dim):
    row_idx = jnp.repeat(jnp.arange(rows), GRID_W).astype(jnp.float32)
    col_idx = jnp.tile(jnp.arange(GRID_W), rows).astype(jnp.float32)
    d_axis = rope_dim // 2
    inv_freq = ROPE_THETA ** (-jnp.arange(0, d_axis, 2, dtype=jnp.float32) / d_axis)
    ang = jnp.concatenate([row_idx[:, None] * inv_freq, col_idx[:, None] * inv_freq], axis=-1)
    return jnp.cos(ang), jnp.sin(ang)


def _apply_rope(x, cos, sin):
    shape = (1, cos.shape[0]) + (1,) * (x.ndim - 3) + (cos.shape[1],)
    cos = cos.reshape(shape).astype(x.dtype)
    sin = sin.reshape(shape).astype(x.dtype)
    xr = x.reshape(x.shape[:-1] + (-1, 2))
    x1, x2 = xr[..., 0], xr[..., 1]
    return jnp.stack([x1 * cos - x2 * sin, x1 * sin + x2 * cos], axis=-1).reshape(x.shape)


def _attend(q, k, v, scale, mask=None, sink=None):
    s = jnp.einsum("bqhgd,bkhd->bhgqk", q, k).astype(jnp.float32) * scale
    if mask is not None:
        s = jnp.where(mask, s, NEG_INF)
    if sink is not None:
        sink_col = jnp.broadcast_to(sink.astype(jnp.float32)[None, :, :, None, None], s.shape[:-1] + (1,))
        p = jax.nn.softmax(jnp.concatenate([s, sink_col], axis=-1), axis=-1)[..., :-1]
    else:
        p = jax.nn.softmax(s, axis=-1)
    return jnp.einsum("bhgqk,bkhd->bqhgd", p.astype(v.dtype), v)


def _blocked_attention(q, k, v, scale):
    bsz, n, hk, g, dq = q.shape
    nb = n // Q_BLOCK
    qb = jnp.moveaxis(q.reshape(bsz, nb, Q_BLOCK, hk, g, dq), 1, 0)
    ob = lax.map(lambda qi: _attend(qi, k, v, scale), qb)
    return jnp.moveaxis(ob, 0, 1).reshape(bsz, n, hk, g, v.shape[-1])


def _window_attention(q, k, v, k_ctx, v_ctx, sink, scale):
    bsz, n, hk, g, dh = q.shape
    nb = n // Q_BLOCK
    span = Q_BLOCK + 2 * WINDOW
    pad = ((0, 0), (WINDOW, WINDOW), (0, 0), (0, 0))
    kp = jnp.pad(k, pad)
    vp = jnp.pad(v, pad)
    qb = jnp.moveaxis(q.reshape(bsz, nb, Q_BLOCK, hk, g, dh), 1, 0)
    r = jnp.arange(Q_BLOCK)[:, None]
    j = jnp.arange(span)[None, :]
    band = (j >= r) & (j <= r + 2 * WINDOW)
    ctx_mask = jnp.ones((Q_BLOCK, k_ctx.shape[1]), dtype=bool)

    def block(args):
        i, qi = args
        start = i * Q_BLOCK
        ki = lax.dynamic_slice_in_dim(kp, start, span, axis=1)
        vi = lax.dynamic_slice_in_dim(vp, start, span, axis=1)
        pos = start - WINDOW + j
        valid = band & (pos >= 0) & (pos < n)
        mask = jnp.concatenate([ctx_mask, valid], axis=1)
        return _attend(qi, jnp.concatenate([k_ctx, ki], axis=1), jnp.concatenate([v_ctx, vi], axis=1), scale, mask, sink)

    ob = lax.map(block, (jnp.arange(nb), qb))
    return jnp.moveaxis(ob, 0, 1).reshape(bsz, n, hk, g, dh)


def _dwconv3(x, w, b):
    xp = jnp.pad(x, ((0, 0), (1, 1), (0, 0)))
    return xp[:, :-2] * w[0] + xp[:, 1:-1] * w[1] + xp[:, 2:] * w[2] + b


def _hyena_filters(n, w1, b1, w2, b2, w3, b3, w4, freq):
    t = jnp.linspace(0.0, 1.0, n, dtype=jnp.float32)[:, None]
    w = 2 * math.pi * jnp.arange(n, dtype=jnp.float32)[:, None] / n
    f = jnp.linspace(1e-4, C_BANDS - 1, C_BANDS, dtype=jnp.float32)[None, :]
    z = jnp.concatenate([t, jnp.cos(f * w), -jnp.sin(f * w)], axis=-1).astype(w1.dtype)
    h = jnp.sin(freq[0] * (z @ w1 + b1))
    h = jnp.sin(freq[1] * (h @ w2 + b2))
    h = jnp.sin(freq[2] * (h @ w3 + b3))
    h = (h @ w4).reshape(n, 2, C_WIDTH)
    deltas = jnp.abs(jnp.linspace(C_MIN_DECAY, C_MAX_DECAY, C_WIDTH, dtype=jnp.float32))
    h = h * jnp.exp(-t[:, :, None] * deltas)
    return h[:, 0], h[:, 1]


def _bidir_long_conv(u, h_fwd, h_bwd, bias):
    n = u.shape[1]
    n_fft = 2 * n
    k_full = jnp.concatenate([h_fwd, jnp.zeros_like(h_fwd[:1]), h_bwd[:0:-1]], axis=0).astype(jnp.float32)
    k_f = jnp.fft.rfft(k_full, n=n_fft, axis=0)
    uf = u.astype(jnp.float32)
    u_f = jnp.fft.rfft(uf, n=n_fft, axis=1)
    y = jnp.fft.irfft(u_f * k_f[None], n=n_fft, axis=1)[:, :n]
    return (y + uf * bias.astype(jnp.float32)).astype(u.dtype)


def _hyena(z, conv_w, conv_b, filt, bias):
    z = _dwconv3(z, conv_w, conv_b)
    x0, x1, v = _split(z, (C_WIDTH, C_WIDTH, C_WIDTH))
    h_fwd, h_bwd = _hyena_filters(z.shape[1], *filt)
    return x0 * _bidir_long_conv(v * x1, h_fwd, h_bwd, bias)


def _a_queries(za, gain, rope):
    bsz, n = za.shape[:2]
    q = _rmsnorm(za.reshape(bsz, n, A_KV_HEADS, A_GROUP, HEAD_DIM), gain)
    return q if rope is None else _apply_rope(q, *rope)


def _a_keys_values(zk, zv, gain, rope):
    bsz, n = zk.shape[:2]
    k = _rmsnorm(zk.reshape(bsz, n, A_KV_HEADS, HEAD_DIM), gain)
    if rope is not None:
        k = _apply_rope(k, *rope)
    return k, zv.reshape(bsz, n, A_KV_HEADS, HEAD_DIM)


def _b_queries(zcq, gain, w_uq, rope):
    bsz, n = zcq.shape[:2]
    q = (_rmsnorm(zcq, gain) @ w_uq).reshape(bsz, n, B_HEADS, 1, B_NOPE + B_ROPE)
    if rope is not None:
        q = jnp.concatenate([q[..., :B_NOPE], _apply_rope(q[..., B_NOPE:], *rope)], axis=-1)
    return q


def _b_keys_values(zckv, zkr, gain, w_ukv, rope):
    bsz, n = zckv.shape[:2]
    kv = (_rmsnorm(zckv, gain) @ w_ukv).reshape(bsz, n, B_HEADS, B_NOPE + B_VDIM)
    k_nope, v = _split(kv, (B_NOPE, B_VDIM))
    k_rope = zkr[:, :, None, :]
    if rope is not None:
        k_rope = _apply_rope(k_rope, *rope)
    k = jnp.concatenate([k_nope, jnp.broadcast_to(k_rope, (bsz, n, B_HEADS, B_ROPE))], axis=-1)
    return k, v


def _d_queries(zq, rope):
    bsz, n = zq.shape[:2]
    q = zq.reshape(bsz, n, D_KV_HEADS, D_GROUP, HEAD_DIM)
    return q if rope is None else _apply_rope(q, *rope)


def _d_keys_values(zk, zv, rope):
    bsz, n = zk.shape[:2]
    k = zk.reshape(bsz, n, D_KV_HEADS, HEAD_DIM)
    if rope is not None:
        k = _apply_rope(k, *rope)
    return k, zv.reshape(bsz, n, D_KV_HEADS, HEAD_DIM)


def _even_mixer(h_lat, h_ctx, need_ctx, rope_hd, rope_mla, w_in, w_out, a_qn, a_kn, b_qn, b_w_uq, b_kvn, b_w_ukv):
    bsz, n = h_lat.shape[:2]
    za_q, zb_q, za_k, za_v, zb_kv, zb_kr = _split(h_lat @ w_in, EV_SIZES)
    ca_k, ca_v, cb_kv, cb_kr = _split(h_ctx @ w_in[:, EV_Q_COLS:], EV_SIZES[2:])
    ka_c, va_c = _a_keys_values(ca_k, ca_v, a_kn, None)
    kb_c, vb_c = _b_keys_values(cb_kv, cb_kr, b_kvn, b_w_ukv, None)
    ka, va = _a_keys_values(za_k, za_v, a_kn, rope_hd)
    kb, vb = _b_keys_values(zb_kv, zb_kr, b_kvn, b_w_ukv, rope_mla)
    oa = _blocked_attention(_a_queries(za_q, a_qn, rope_hd),
                            jnp.concatenate([ka_c, ka], axis=1), jnp.concatenate([va_c, va], axis=1), A_SCALE)
    ob = _blocked_attention(_b_queries(zb_q, b_qn, b_w_uq, rope_mla),
                            jnp.concatenate([kb_c, kb], axis=1), jnp.concatenate([vb_c, vb], axis=1), B_SCALE)
    y_lat = jnp.concatenate([oa.reshape(bsz, n, -1), ob.reshape(bsz, n, -1)], axis=-1) @ w_out
    if not need_ctx:
        return y_lat, None
    m = h_ctx.shape[1]
    ca_q, cb_q = _split(h_ctx @ w_in[:, :EV_Q_COLS], EV_SIZES[:2])
    oa_c = _attend(_a_queries(ca_q, a_qn, None), ka_c, va_c, A_SCALE)
    ob_c = _attend(_b_queries(cb_q, b_qn, b_w_uq, None), kb_c, vb_c, B_SCALE)
    y_ctx = jnp.concatenate([oa_c.reshape(bsz, m, -1), ob_c.reshape(bsz, m, -1)], axis=-1) @ w_out
    return y_lat, y_ctx


def _odd_mixer(h_lat, h_ctx, need_ctx, rope_hd, w_in, w_out, sink, conv_w, conv_b, filt, c_bias):
    bsz, n = h_lat.shape[:2]
    sink = sink.reshape(D_KV_HEADS, D_GROUP)
    zd_q, zc, zd_k, zd_v = _split(h_lat @ w_in, OD_SIZES)
    cd_k, cd_v = _split(h_ctx @ w_in[:, OD_Q_COLS:], OD_SIZES[2:])
    kd_c, vd_c = _d_keys_values(cd_k, cd_v, None)
    kd, vd = _d_keys_values(zd_k, zd_v, rope_hd)
    od = _window_attention(_d_queries(zd_q, rope_hd), kd, vd, kd_c, vd_c, sink, D_SCALE)
    oc = _hyena(zc, conv_w, conv_b, filt, c_bias)
    y_lat = jnp.concatenate([od.reshape(bsz, n, -1), oc], axis=-1) @ w_out
    if not need_ctx:
        return y_lat, None
    m = h_ctx.shape[1]
    cd_q, cc = _split(h_ctx @ w_in[:, :OD_Q_COLS], OD_SIZES[:2])
    od_c = _attend(_d_queries(cd_q, None), kd_c, vd_c, D_SCALE, sink=sink)
    oc_c = _hyena(cc, conv_w, conv_b, filt, c_bias)
    y_ctx = jnp.concatenate([od_c.reshape(bsz, m, -1), oc_c], axis=-1) @ w_out
    return y_lat, y_ctx


def _conv_ffn(h, w_up, conv_w, conv_b, w_down):
    g, v = _split(_dwconv3(h @ w_up, conv_w, conv_b), (FFN_DIM, FFN_DIM))
    return (jax.nn.silu(g) * v) @ w_down


def setup_inputs(seed: int = 0) -> dict:
    key = jax.random.key(seed)
    keys = iter(jax.random.split(key, 40))

    def nrm(shape, scale):
        return jax.random.normal(next(keys), shape, jnp.float32) * scale

    def gain(shape):
        return 1.0 + nrm(shape, 0.05)

    n_even = (DEPTH + 1) // 2
    n_odd = DEPTH // 2
    return {
        "x": nrm((BATCH, SEQ, D_MODEL), 1.0),
        "c": nrm((BATCH, D_MODEL), 1.0),
        "ctx": nrm((BATCH, CTX_LEN, D_MODEL), 1.0),
        "c_ctx": nrm((D_MODEL,), 1.0),
        "w_mod": nrm((DEPTH, D_MODEL, N_MOD * D_MODEL), 0.5 * D_MODEL ** -0.5),
        "b_mod": nrm((DEPTH, N_MOD * D_MODEL), 0.02),
        "norm_mix": gain((DEPTH, D_MODEL)),
        "norm_ffn": gain((DEPTH, D_MODEL)),
        "ev_w_in": nrm((n_even, D_MODEL, EV_COLS), D_MODEL ** -0.5),
        "ev_w_out": nrm((n_even, EV_OUT, D_MODEL), EV_OUT ** -0.5),
        "a_q_norm": gain((n_even, HEAD_DIM)),
        "a_k_norm": gain((n_even, HEAD_DIM)),
        "b_q_norm": gain((n_even, B_Q_RANK)),
        "b_w_uq": nrm((n_even, B_Q_RANK, B_HEADS * (B_NOPE + B_ROPE)), B_Q_RANK ** -0.5),
        "b_kv_norm": gain((n_even, B_KV_RANK)),
        "b_w_ukv": nrm((n_even, B_KV_RANK, B_HEADS * (B_NOPE + B_VDIM)), B_KV_RANK ** -0.5),
        "od_w_in": nrm((n_odd, D_MODEL, OD_COLS), D_MODEL ** -0.5),
        "od_w_out": nrm((n_odd, OD_OUT, D_MODEL), OD_OUT ** -0.5),
        "d_sink": nrm((n_odd, D_HEADS), 0.5),
        "c_conv_w": nrm((n_odd, 3, 3 * C_WIDTH), 3 ** -0.5),
        "c_conv_b": nrm((n_odd, 3 * C_WIDTH), 0.02),
        "c_filt_w1": nrm((n_odd, C_EMB_DIM, C_FILTER_WIDTH), 1.0),
        "c_filt_b1": nrm((n_odd, C_FILTER_WIDTH), 0.1),
        "c_filt_w2": nrm((n_odd, C_FILTER_WIDTH, C_FILTER_WIDTH), C_FILTER_WIDTH ** -0.5),
        "c_filt_b2": nrm((n_odd, C_FILTER_WIDTH), 0.1),
        "c_filt_w3": nrm((n_odd, C_FILTER_WIDTH, C_FILTER_WIDTH), C_FILTER_WIDTH ** -0.5),
        "c_filt_b3": nrm((n_odd, C_FILTER_WIDTH), 0.1),
        "c_filt_w4": nrm((n_odd, C_FILTER_WIDTH, 2 * C_WIDTH), 0.05 * C_FILTER_WIDTH ** -0.5),
        "c_filt_freq": gain((n_odd, 3, C_FILTER_WIDTH)),
        "c_bias": nrm((n_odd, C_WIDTH), 0.5),
        "ffn_w_up": nrm((DEPTH, D_MODEL, 2 * FFN_DIM), D_MODEL ** -0.5),
        "ffn_conv_w": nrm((DEPTH, 3, 2 * FFN_DIM), 3 ** -0.5),
        "ffn_conv_b": nrm((DEPTH, 2 * FFN_DIM), 0.02),
        "ffn_w_down": nrm((DEPTH, FFN_DIM, D_MODEL), FFN_DIM ** -0.5),
        "final_norm": gain((D_MODEL,)),
    }


def reference(x, c, ctx, c_ctx, w_mod, b_mod, norm_mix, norm_ffn,
              ev_w_in, ev_w_out, a_q_norm, a_k_norm, b_q_norm, b_w_uq, b_kv_norm, b_w_ukv,
              od_w_in, od_w_out, d_sink, c_conv_w, c_conv_b,
              c_filt_w1, c_filt_b1, c_filt_w2, c_filt_b2, c_filt_w3, c_filt_b3, c_filt_w4, c_filt_freq, c_bias,
              ffn_w_up, ffn_conv_w, ffn_conv_b, ffn_w_down, final_norm):
    rows = x.shape[1] // GRID_W
    rope_hd = _axial_rope(rows, HEAD_DIM)
    rope_mla = _axial_rope(rows, B_ROPE)
    silu_c = jax.nn.silu(c)
    silu_cc = jax.nn.silu(c_ctx)
    for layer in range(DEPTH):
        need_ctx = layer < DEPTH - 1
        mods_l = _split(silu_c @ w_mod[layer] + b_mod[layer], (D_MODEL,) * N_MOD)
        sh_l, sc_l, gt_l, sh2_l, sc2_l, gt2_l = [m_[:, None, :] for m_ in mods_l]
        sh_c, sc_c, gt_c, sh2_c, sc2_c, gt2_c = _split(silu_cc @ w_mod[layer] + b_mod[layer], (D_MODEL,) * N_MOD)
        h_lat = _modulate(_rmsnorm(x, norm_mix[layer]), sh_l, sc_l)
        h_ctx = _modulate(_rmsnorm(ctx, norm_mix[layer]), sh_c, sc_c)
        if layer % 2 == 0:
            e = layer // 2
            y_lat, y_ctx = _even_mixer(h_lat, h_ctx, need_ctx, rope_hd, rope_mla, ev_w_in[e], ev_w_out[e],
                                       a_q_norm[e], a_k_norm[e], b_q_norm[e], b_w_uq[e], b_kv_norm[e], b_w_ukv[e])
        else:
            o = layer // 2
            filt = (c_filt_w1[o], c_filt_b1[o], c_filt_w2[o], c_filt_b2[o], c_filt_w3[o], c_filt_b3[o],
                    c_filt_w4[o], c_filt_freq[o])
            y_lat, y_ctx = _odd_mixer(h_lat, h_ctx, need_ctx, rope_hd, od_w_in[o], od_w_out[o], d_sink[o],
                                      c_conv_w[o], c_conv_b[o], filt, c_bias[o])
        x = x + gt_l * y_lat
        x = x + gt2_l * _conv_ffn(_modulate(_rmsnorm(x, norm_ffn[layer]), sh2_l, sc2_l),
                                  ffn_w_up[layer], ffn_conv_w[layer], ffn_conv_b[layer], ffn_w_down[layer])
        if need_ctx:
            ctx = ctx + gt_c * y_ctx
            ctx = ctx + gt2_c * _conv_ffn(_modulate(_rmsnorm(ctx, norm_ffn[layer]), sh2_c, sc2_c),
                                          ffn_w_up[layer], ffn_conv_w[layer], ffn_conv_b[layer], ffn_w_down[layer])
    return _rmsnorm(x, final_norm)
```

```cpp
#include <hip/hip_runtime.h>
#include <hip/hip_cooperative_groups.h>
#include <cstdio>
namespace cg = cooperative_groups;

typedef unsigned short u16;
typedef __attribute__((ext_vector_type(8))) short bf16x8;
typedef __attribute__((ext_vector_type(4))) short s16x4;
typedef __attribute__((ext_vector_type(4))) float f32x4;
typedef __attribute__((ext_vector_type(16))) float f32x16;
typedef __bf16 bf16x2_t __attribute__((ext_vector_type(2)));
typedef float f2_t __attribute__((ext_vector_type(2)));
#define DI __device__ __forceinline__

#define REP_ATT0 1
#define REP_FFNUP 1
#define REP_L1MIX 1
#define REP_DOWN0 1
constexpr int NT = 256;
constexpr int R_LAT = 32768, R_ALL = 34816, DM = 1024;
constexpr int NKEY = 4352;
constexpr float LOG2E = 1.4426950408889634f;
constexpr float EPS = 1e-6f;
constexpr int VLDS = 66560;
constexpr int LDS_BYTES = 2 * VLDS;
constexpr int PT = 512;

constexpr size_t OFF_WEVIN = 0;
constexpr size_t OFF_WEVOUT = OFF_WEVIN + 1536ull * 1024 * 2;
constexpr size_t OFF_WUQ = OFF_WEVOUT + 1024ull * 1024 * 2;
constexpr size_t OFF_WUKV = OFF_WUQ + 768ull * 384 * 2;
constexpr size_t OFF_WODIN = OFF_WUKV + 1024ull * 256 * 2;
constexpr size_t OFF_WODOUT = OFF_WODIN + 2304ull * 1024 * 2;
constexpr size_t OFF_WUP = OFF_WODOUT + 1024ull * 1024 * 2;
constexpr size_t OFF_WDOWN = OFF_WUP + 2ull * 5632 * 1024 * 2;
constexpr size_t OFF_MODS = OFF_WDOWN + 2ull * 1024 * 2816 * 2;
constexpr size_t OFF_ROPE = OFF_MODS + 2ull * 9 * 6144 * 4;
constexpr size_t OFF_TW = OFF_ROPE + 12288;
constexpr size_t OFF_KF = OFF_TW + 4096 * 8;
constexpr size_t OFF_CTXX = OFF_KF + 512ull * 8192 * 4;
constexpr size_t OFF_H = OFF_CTXX + 2048ull * 1024 * 4;
constexpr size_t OFF_Z = OFF_H + (size_t)R_ALL * 1024 * 2;
constexpr size_t OFF_CQ = OFF_Z + (size_t)R_ALL * 1440 * 2;
constexpr size_t OFF_CKV = OFF_CQ + (size_t)R_ALL * 384 * 2;
constexpr size_t OFF_QKV = OFF_Z + (size_t)R_ALL * 2304 * 2;
constexpr size_t OFF_QA = OFF_QKV;
constexpr size_t OFF_KA = OFF_QA + 8ull * 8 * NKEY * 64 * 2;
constexpr size_t OFF_VAT = OFF_KA + 8ull * 2 * NKEY * 64 * 2;
constexpr size_t OFF_QB = OFF_VAT + 8ull * 2 * NKEY * 64 * 2;
constexpr size_t OFF_KB = OFF_QB + 8ull * 8 * NKEY * 96 * 2;
constexpr size_t OFF_VBT = OFF_KB + 8ull * 8 * NKEY * 96 * 2;
constexpr size_t END_L0 = OFF_VBT + 8ull * 8 * NKEY * 64 * 2;
constexpr size_t OFF_QD = OFF_QKV;
constexpr size_t OFF_KD = OFF_QD + 8ull * 8 * NKEY * 64 * 2;
constexpr size_t OFF_VDT = OFF_KD + 8ull * 2 * NKEY * 64 * 2;
constexpr size_t OFF_U = OFF_VDT + 8ull * 2 * NKEY * 64 * 2;
constexpr size_t OFF_X0 = OFF_U + 512ull * 8 * 4096 * 4;
constexpr size_t OFF_Y = OFF_X0 + 32768ull * 512 * 2;
constexpr size_t END_L1 = OFF_Y + 512ull * 8 * 4096 * 4;
constexpr size_t OFF_ACT = OFF_Z;
constexpr size_t WS_NEED = (END_L0 > END_L1 ? END_L0 : END_L1);
constexpr size_t OFF_TAB = WS_NEED;
constexpr size_t OFF_BAR = OFF_TAB + 512;
constexpr size_t OFF_EDGE = OFF_Y + 36ull * 1024 * 1024;
static_assert(OFF_EDGE + 136ull * 4 * 5632 * 4 <= END_L1, "edge");
constexpr size_t OFF_ZERO = OFF_BAR + 3456 * 4;
static_assert(OFF_ZERO + 8192 <= 536870912ull, "workspace too large");
static_assert(OFF_CKV + (size_t)R_ALL * 256 * 2 <= OFF_QKV, "cq/ckv overflow");
static_assert(OFF_ACT + (size_t)R_ALL * 2816 * 2 <= WS_NEED, "act");

struct P {
  const float* in[35];
  float* out;
  char* ws;
  int use_cg_sync;
  int pad_;
};
enum { I_X, I_C, I_CTX, I_CCTX, I_WMOD, I_BMOD, I_NMIX, I_NFFN, I_EVIN, I_EVOUT, I_AQN, I_AKN, I_BQN, I_WUQ, I_BKVN, I_WUKV,
       I_ODIN, I_ODOUT, I_SINK, I_CCW, I_CCB, I_FW1, I_FB1, I_FW2, I_FB2, I_FW3, I_FB3, I_FW4, I_FFREQ, I_CBIAS,
       I_FUP, I_FCW, I_FCB, I_FDOWN, I_FNORM };

#define PIN0(i) (p.in[i])
#define PIN(i) (((const float* const*)(p.ws + OFF_TAB))[i])
DI int PTID() { int t = threadIdx.x; asm volatile("" : "+v"(t)); return t; }
DI int TID() { int t = threadIdx.x & 255; asm volatile("" : "+v"(t)); return t; }
DI int VHALF() { return (int)(threadIdx.x >> 8); }
DI int VB() { return (int)blockIdx.x * 2 + VHALF(); }
DI int NVB() { return (int)gridDim.x * 2; }
DI u16 f2bf(float x) { unsigned u = __float_as_uint(x); u += 0x7fffu + ((u >> 16) & 1u); return (u16)(u >> 16); }
DI float bf2f(u16 h) { return __uint_as_float(((unsigned)h) << 16); }
DI unsigned pack2(float a, float b) { f2_t v = {a, b}; bf16x2_t r = __builtin_convertvector(v, bf16x2_t); return __builtin_bit_cast(unsigned, r); }
DI float wave_sum(float v) { for (int o = 32; o > 0; o >>= 1) v += __shfl_xor(v, o); return v; }
DI void unpack8(uint4 q, float* f) {
  f[0] = __uint_as_float(q.x << 16); f[1] = __uint_as_float(q.x & 0xffff0000u);
  f[2] = __uint_as_float(q.y << 16); f[3] = __uint_as_float(q.y & 0xffff0000u);
  f[4] = __uint_as_float(q.z << 16); f[5] = __uint_as_float(q.z & 0xffff0000u);
  f[6] = __uint_as_float(q.w << 16); f[7] = __uint_as_float(q.w & 0xffff0000u);
}
DI uint4 pack8(const float* f) { uint4 q; q.x = pack2(f[0], f[1]); q.y = pack2(f[2], f[3]); q.z = pack2(f[4], f[5]); q.w = pack2(f[6], f[7]); return q; }


#define XB_TMO      128
#define XB_XCNT(j)  (256  + 64 * (j))
#define XB_XSUB(j)  (1280 + 64 * (j))
#define XB_XGEN(j)  (2304 + 64 * (j))
#define XB_TOP      3328
#define XB_TOPGEN   3392
#define XCD_BAR_WORDS 3456
#define XB_SPIN_CAP (1u << 18)
#define LAS __attribute__((address_space(3)))
DI unsigned xb_ld(unsigned* p) { return __hip_atomic_load(p, __ATOMIC_RELAXED, __HIP_MEMORY_SCOPE_AGENT); }
DI unsigned xb_add(unsigned* p, unsigned v) { return __hip_atomic_fetch_add(p, v, __ATOMIC_RELAXED, __HIP_MEMORY_SCOPE_AGENT); }
DI unsigned xb_xcc_id() { return (unsigned)__builtin_amdgcn_s_getreg((3 << 11) | 20) & 0xFu; }
#define XB_SPIN(cond, bar) do { unsigned _sp = 0; while (cond) { __builtin_amdgcn_s_sleep(1); \
    if ((++_sp & 255u) == 0u) { if (xb_ld(&(bar)[XB_TMO])) break; if (_sp > XB_SPIN_CAP) { atomicAdd(&(bar)[XB_TMO], 1u); break; } } } } while (0)
struct XcdBarrier { unsigned* bar; unsigned x; volatile LAS unsigned* st; };
DI XcdBarrier xcd_barrier_post(unsigned* bar, volatile LAS unsigned* st) {
  XcdBarrier b; b.bar = bar; b.x = xb_xcc_id(); b.st = st;
  if (threadIdx.x == 0) (void)xb_add(&bar[XB_XCNT(b.x)], 1u);
  return b;
}
DI void xcd_barrier_complete(unsigned* bar, unsigned x, unsigned& nloc, unsigned& nx) {
  const unsigned G = gridDim.x * gridDim.y * gridDim.z;
  unsigned sum, cnt, mine, sp = 0u;
  for (;;) {
    sum = 0u; cnt = 0u; mine = 0u;
#pragma unroll
    for (unsigned j = 0; j < 16; ++j) { const unsigned c = xb_ld(&bar[XB_XCNT(j)]); sum += c; cnt += (c > 0u) ? 1u : 0u; mine = (j == x) ? c : mine; }
    if (sum == G) break;
    __builtin_amdgcn_s_sleep(1);
    if ((++sp & 255u) == 0u) { if (xb_ld(&bar[XB_TMO])) break; if (sp > XB_SPIN_CAP) { atomicAdd(&bar[XB_TMO], 1u); break; } }
  }
  nloc = mine > 0u ? mine : 1u; nx = cnt > 0u ? cnt : 1u;
}
DI void xcd_barrier(const XcdBarrier& b) {
  asm volatile("s_waitcnt vmcnt(0)" ::: "memory");
  __syncthreads();
  if (threadIdx.x == 0) {
    unsigned* bar = b.bar;
    __builtin_amdgcn_s_waitcnt(0);
    unsigned nloc = b.st[0], nx = b.st[1];
    if (nloc == 0u) { xcd_barrier_complete(bar, b.x, nloc, nx); b.st[0] = nloc; b.st[1] = nx; }
    const unsigned old = xb_add(&bar[XB_XSUB(b.x)], 1u);
    const unsigned gen = old / nloc;
    if (old + 1u == (gen + 1u) * nloc) {
      __builtin_amdgcn_fence(__ATOMIC_RELEASE, "agent");
      asm volatile("s_waitcnt vmcnt(0)" ::: "memory");
      const unsigned og = xb_add(&bar[XB_TOP], 1u);
      const unsigned tg = og / nx;
      if (og + 1u == (tg + 1u) * nx) xb_add(&bar[XB_TOPGEN], 1u);
      else XB_SPIN(xb_ld(&bar[XB_TOPGEN]) == tg, bar);
      __builtin_amdgcn_fence(__ATOMIC_ACQUIRE, "agent");
      xb_add(&bar[XB_XGEN(b.x)], 1u);
      asm volatile("s_waitcnt vmcnt(0)" ::: "memory");
    } else {
      XB_SPIN(xb_ld(&bar[XB_XGEN(b.x)]) == gen, bar);
      __builtin_amdgcn_fence(__ATOMIC_ACQUIRE, "agent");
      asm volatile("s_waitcnt vmcnt(0)" ::: "memory");
    }
  }
  __syncthreads();
}

struct JobIter { int j, end, step, n; };
DI JobIter vjobs_plain(int J) {
  JobIter it; int b2 = (int)blockIdx.x * 2, nvb = NVB();
  it.j = b2 + VHALF(); it.end = J; it.step = nvb; it.n = (J > b2) ? (J - b2 + nvb - 1) / nvb : 0;
  return it;
}
DI JobIter vjobs_xcd(int J) {
  int b = blockIdx.x, nb = gridDim.x;
  if (nb & 7) return vjobs_plain(J);
  JobIter it;
  int x = b & 7, r0 = (b >> 3) * 2, chunk = (J + 7) >> 3;
  int lo = x * chunk, hi = lo + chunk < J ? lo + chunk : J;
  it.step = (nb >> 3) * 2; it.j = lo + r0 + VHALF(); it.end = hi;
  it.n = (hi - lo > r0) ? (hi - lo - r0 + it.step - 1) / it.step : 0;
  return it;
}
#define VJOB_LOOP(it, job) for (int t_ = 0, j_ = (it).j, job = 0; t_ < (it).n && ((job = j_ < (it).end ? j_ : (it).end - 1), true); ++t_, j_ += (it).step)
DI JobIter xcd_jobs(int J) {
  int b = blockIdx.x, nb = gridDim.x;
  JobIter it; it.n = 0;
  if ((nb & 7) == 0) {
    int x = b & 7, r = b >> 3, chunk = (J + 7) >> 3;
    int lo = x * chunk, hi = lo + chunk < J ? lo + chunk : J;
    it.j = lo + r; it.end = hi; it.step = nb >> 3;
  } else { it.j = b; it.end = J; it.step = nb; }
  return it;
}
DI void gemm_decode(int j, int ntn, int& mt, int& nt) { int g = j / (8 * ntn); int rem = j - g * 8 * ntn; nt = rem >> 3; mt = g * 8 + (rem & 7); }

DI int lds_off(int row, int c) { return row * 128 + ((c ^ ((row >> 1) & 7)) << 4); }

#define RAW_BARRIER() do { asm volatile("s_waitcnt lgkmcnt(0)" ::: "memory"); __builtin_amdgcn_s_barrier(); } while (0)
template <int NPASS, class Epi, class Post>
DI void gemm_tile(const u16* __restrict__ zero_row, const u16* __restrict__ A, int lda, int arow0, int alo, int ahi,
                  const u16* __restrict__ W, int ldw, int wq0, int wq1, int wq2, int wq3, int K, char* smem, Epi epi, Post post) {
  const int tid = PTID(), lane = tid & 63, wave = tid >> 6;
  const int wm = wave & 1, wn = wave >> 1;
  f32x4 acc[4][8];
#pragma unroll
  for (int i = 0; i < 4; ++i)
#pragma unroll
    for (int j = 0; j < 8; ++j) acc[i][j] = (f32x4){0.f, 0.f, 0.f, 0.f};
  const int nk = K >> 6;
  const int r8 = lane >> 3, cs = (lane & 7) ^ (((lane >> 4) & 3) + 4 * (wave & 1));
  const u16* pa[4];
#pragma unroll
  for (int i = 0; i < 4; ++i) {
    int r = arow0 + 8 * wave + r8 + 64 * i; bool v = (r >= alo && r < ahi);
    pa[i] = (v ? A + (size_t)r * lda : zero_row) + cs * 8;
  }
  const u16* pw0 = W + (size_t)(wq0 + 8 * wave + r8) * ldw + cs * 8;
  const u16* pw1 = W + (size_t)(wq1 + 8 * wave + r8) * ldw + cs * 8;
  const u16* pw2 = W + (size_t)(wq2 + 8 * wave + r8) * ldw + cs * 8;
  const u16* pw3 = W + (size_t)(wq3 + 8 * wave + r8) * ldw + cs * 8;
  char* dmab = smem + wave * 1024;
#define GLDS(KT)                                                                                         \
  {                                                                                                      \
    int ko_ = (KT) * 64; char* d_ = dmab + ((KT) & 1) * 65536;                                           \
    __builtin_amdgcn_global_load_lds((const unsigned*)(pa[0] + ko_), (unsigned*)(d_), 16, 0, 0);         \
    __builtin_amdgcn_global_load_lds((const unsigned*)(pa[1] + ko_), (unsigned*)(d_ + 8192), 16, 0, 0);  \
    __builtin_amdgcn_global_load_lds((const unsigned*)(pa[2] + ko_), (unsigned*)(d_ + 16384), 16, 0, 0); \
    __builtin_amdgcn_global_load_lds((const unsigned*)(pa[3] + ko_), (unsigned*)(d_ + 24576), 16, 0, 0); \
    __builtin_amdgcn_global_load_lds((const unsigned*)(pw0 + ko_), (unsigned*)(d_ + 32768), 16, 0, 0);   \
    __builtin_amdgcn_global_load_lds((const unsigned*)(pw1 + ko_), (unsigned*)(d_ + 40960), 16, 0, 0);   \
    __builtin_amdgcn_global_load_lds((const unsigned*)(pw2 + ko_), (unsigned*)(d_ + 49152), 16, 0, 0);   \
    __builtin_amdgcn_global_load_lds((const unsigned*)(pw3 + ko_), (unsigned*)(d_ + 57344), 16, 0, 0);   \
  }
  const int fro = lds_off(lane & 15, lane >> 4);
  __syncthreads();
  GLDS(0);
  GLDS(1);
  asm volatile("s_waitcnt vmcnt(8)" ::: "memory");
  RAW_BARRIER();
#define RD4(dst, base, first) { _Pragma("unroll") for (int i_ = 0; i_ < 4; ++i_) dst[i_] = *(const bf16x8*)((base) + ((first) + i_) * 2048); }
#define MM16(fw, fa, mbase) { _Pragma("unroll") for (int mi_ = 0; mi_ < 4; ++mi_) _Pragma("unroll") for (int ni_ = 0; ni_ < 4; ++ni_) \
      acc[ni_][(mbase) + mi_] = __builtin_amdgcn_mfma_f32_16x16x32_bf16(fw[ni_], fa[mi_], acc[ni_][(mbase) + mi_], 0, 0, 0); }
#pragma unroll 1
  for (int kt = 0; kt < nk; ++kt) {
    const char* st_ = smem + (kt & 1) * 65536;
    const char* a0_ = st_ + wm * 16384 + fro;
    const char* w0_ = st_ + 32768 + wn * 8192 + fro;
    const char* a1_ = st_ + wm * 16384 + (fro ^ 64);
    const char* w1_ = st_ + 32768 + wn * 8192 + (fro ^ 64);
    bf16x8 fwA[4], fwB[4], faA[4], faB[4];
    RD4(fwA, w0_, 0); RD4(faA, a0_, 0);
    __builtin_amdgcn_sched_barrier(0);
    RD4(faB, a0_, 4); RD4(fwB, w1_, 0);
    __builtin_amdgcn_sched_barrier(0);
    MM16(fwA, faA, 0);
    RD4(faA, a1_, 0);
    MM16(fwA, faB, 4);
    RD4(faB, a1_, 4);
    MM16(fwB, faA, 0);
    MM16(fwB, faB, 4);
    __builtin_amdgcn_sched_barrier(0);
    asm volatile("s_waitcnt vmcnt(0)" ::: "memory");
    RAW_BARRIER();
    if (kt + 2 < nk) GLDS(kt + 2);
  }
#undef GLDS
#undef RD4
#undef MM16
#pragma unroll
  for (int ph = 0; ph < NPASS; ++ph) {
    if (NPASS == 1 || (wn >> 1) == ph) {
#pragma unroll
      for (int ni = 0; ni < 4; ++ni)
#pragma unroll
        for (int mi = 0; mi < 8; ++mi)
          epi(wm * 128 + mi * 16 + (lane & 15), wn * 64 + ni * 16 + (lane >> 4) * 4, acc[ni][mi]);
    }
    post(ph);
  }
}

DI void wconv_tile(const float* __restrict__ src, int K, int N, u16* __restrict__ dst, int tile, float* sm) {
  const int tid = TID();
  int nkt = K >> 6;
  int tn = tile / nkt, tk = tile - tn * nkt;
  int n0 = tn * 128, k0 = tk * 64;
  float v[32];
  const int n = n0 + (tid & 63);
#pragma unroll
  for (int i = 0; i < 16; ++i) {
    int kk = (tid >> 6) + 4 * i;
    const float* sp = src + (size_t)(k0 + kk) * N + n;
    v[2 * i] = (n < N) ? sp[0] : 0.f;
    v[2 * i + 1] = (n + 64 < N) ? sp[64] : 0.f;
  }
  __syncthreads();
#pragma unroll
  for (int i = 0; i < 16; ++i) {
    int kk = (tid >> 6) + 4 * i;
    sm[kk * 65 + (tid & 63)] = v[2 * i];
    sm[4160 + kk * 65 + (tid & 63)] = v[2 * i + 1];
  }
  __syncthreads();
#pragma unroll 8
  for (int i = 0; i < 32; ++i) {
    int nn = (tid >> 6) + 4 * i;
    float x = sm[(nn >> 6) * 4160 + (tid & 63) * 65 + (nn & 63)];
    dst[(size_t)(n0 + nn) * K + k0 + (tid & 63)] = (u16)(pack2(x, 0.f) & 0xffffu);
  }
}

DI void mods_job(const P& p, int job, float* sm) {
  const int tid = TID();
  int l = job / 96, cg_ = job - l * 96;
  float* sc = sm;
  float* red = sm + 9 * 1024;
  __syncthreads();
  const float* cvec = PIN0(I_C); const float* ccv = PIN0(I_CCTX);
  for (int i = tid; i < 9 * 1024; i += NT) {
    int j = i >> 10, k = i & 1023;
    float v = (j < 8) ? cvec[j * 1024 + k] : ccv[k];
    sc[i] = v / (1.f + __expf(-v));
  }
  __syncthreads();
  int col = cg_ * 64 + (tid & 63), ks = tid >> 6;
  float acc[9];
#pragma unroll
  for (int j = 0; j < 9; ++j) acc[j] = 0.f;
  const float* w = PIN0(I_WMOD) + (size_t)l * 1024 * 6144 + col;
#pragma unroll 2
  for (int k = ks * 256; k < ks * 256 + 256; k += 4) {
    float w0 = w[(size_t)k * 6144], w1 = w[(size_t)(k + 1) * 6144], w2 = w[(size_t)(k + 2) * 6144], w3 = w[(size_t)(k + 3) * 6144];
#pragma unroll
    for (int j = 0; j < 9; ++j) {
      float4 sv = *(const float4*)(sc + j * 1024 + k);
      acc[j] += sv.x * w0 + sv.y * w1 + sv.z * w2 + sv.w * w3;
    }
  }
#pragma unroll
  for (int j = 0; j < 9; ++j) red[(ks * 9 + j) * 64 + (tid & 63)] = acc[j];
  __syncthreads();
  float* mods = (float*)(p.ws + OFF_MODS);
  for (int i = tid; i < 9 * 64; i += NT) {
    int j = i >> 6, cc = i & 63;
    float s = red[(0 * 9 + j) * 64 + cc] + red[(1 * 9 + j) * 64 + cc] + red[(2 * 9 + j) * 64 + cc] + red[(3 * 9 + j) * 64 + cc];
    int c2 = cg_ * 64 + cc;
    mods[((size_t)l * 9 + j) * 6144 + c2] = s + PIN0(I_BMOD)[l * 6144 + c2];
  }
}

DI void tables_job(const P& p) {
  const int tid = TID();
  float* rope = (float*)(p.ws + OFF_ROPE);
  for (int i = tid; i < 1024; i += NT) {
    int pos = i >> 4, f = i & 15;
    float invf = powf(10000.f, -(float)f / 16.f);
    float ang = (float)pos * invf, s, c;
    sincosf(ang, &s, &c);
    rope[i] = c; rope[1024 + i] = s;
  }
  for (int i = tid; i < 512; i += NT) {
    int pos = i >> 3, f = i & 7;
    float invf = powf(10000.f, -(float)f / 8.f);
    float ang = (float)pos * invf, s, c;
    sincosf(ang, &s, &c);
    rope[2048 + i] = c; rope[2560 + i] = s;
  }
  float2* tw = (float2*)(p.ws + OFF_TW);
  for (int i = tid; i < 4096; i += NT) {
    float s, c;
    sincospif((float)i / 4096.f, &s, &c);
    tw[i] = make_float2(c, -s);
  }
}

DI void filter_job(const P& p, int job, float* sm) {
  const int tid = TID();
  float* ha = sm;
  float* hb = sm + 1024;
  float* zf = sm + 2048;
  __syncthreads();
  if (tid < 16) {
    int pos = job * 16 + tid;
    float t = (float)pos / 4095.f;
    float w = 6.283185307179586f * (float)pos / 4096.f;
    float s0, c0, s1, c1;
    sincosf(1e-4f * w, &s0, &c0);
    sincosf(w, &s1, &c1);
    zf[tid * 8 + 0] = t; zf[tid * 8 + 1] = c0; zf[tid * 8 + 2] = c1; zf[tid * 8 + 3] = -s0; zf[tid * 8 + 4] = -s1;
  }
  __syncthreads();
  const float* fr = PIN0(I_FFREQ);
  const float* fw1 = PIN0(I_FW1); const float* fb1 = PIN0(I_FB1); const float* fw2 = PIN0(I_FW2); const float* fb2 = PIN0(I_FB2);
  const float* fw3 = PIN0(I_FW3); const float* fb3 = PIN0(I_FB3); const float* fw4 = PIN0(I_FW4);
  for (int i = tid; i < 1024; i += NT) {
    int pp = i >> 6, j = i & 63;
    float a = fb1[j];
#pragma unroll
    for (int e = 0; e < 5; ++e) a += zf[pp * 8 + e] * fw1[e * 64 + j];
    ha[i] = sinf(fr[j] * a);
  }
  __syncthreads();
  for (int i = tid; i < 1024; i += NT) {
    int pp = i >> 6, j = i & 63;
    float a = fb2[j];
#pragma unroll 4
    for (int e = 0; e < 64; e += 4) {
      float4 hv = *(const float4*)(ha + pp * 64 + e);
      a += hv.x * fw2[e * 64 + j] + hv.y * fw2[(e + 1) * 64 + j] + hv.z * fw2[(e + 2) * 64 + j] + hv.w * fw2[(e + 3) * 64 + j];
    }
    hb[i] = sinf(fr[64 + j] * a);
  }
  __syncthreads();
  for (int i = tid; i < 1024; i += NT) {
    int pp = i >> 6, j = i & 63;
    float a = fb3[j];
#pragma unroll 4
    for (int e = 0; e < 64; e += 4) {
      float4 hv = *(const float4*)(hb + pp * 64 + e);
      a += hv.x * fw3[e * 64 + j] + hv.y * fw3[(e + 1) * 64 + j] + hv.z * fw3[(e + 2) * 64 + j] + hv.w * fw3[(e + 3) * 64 + j];
    }
    ha[i] = sinf(fr[128 + j] * a);
  }
  __syncthreads();
  float* kf = (float*)(p.ws + OFF_KF);
#pragma unroll 1
  for (int q = 0; q < 4; ++q) {
    int o = tid + 256 * q;
    float acc[16];
#pragma unroll
    for (int pp = 0; pp < 16; ++pp) acc[pp] = 0.f;
#pragma unroll 1
    for (int e = 0; e < 64; e += 4) {
      float w0 = fw4[e * 1024 + o], w1 = fw4[(e + 1) * 1024 + o], w2 = fw4[(e + 2) * 1024 + o], w3 = fw4[(e + 3) * 1024 + o];
#pragma unroll
      for (int pp = 0; pp < 16; ++pp) {
        float4 hv = *(const float4*)(ha + pp * 64 + e);
        acc[pp] += hv.x * w0 + hv.y * w1 + hv.z * w2 + hv.w * w3;
      }
    }
    int c = o & 511, dir = o >> 9;
    const float mind = -3.0701134573253945f, maxd = -15.350567286626973f;
    float delta = fabsf(mind + (maxd - mind) * (float)c / 511.f);
#pragma unroll
    for (int pp = 0; pp < 16; ++pp) {
      int pos = job * 16 + pp;
      float t = (float)pos / 4095.f;
      float v = acc[pp] * __expf(-t * delta);
      if (dir == 0) kf[(size_t)c * 8192 + pos] = v;
      else if (pos > 0) kf[(size_t)c * 8192 + 8192 - pos] = v;
      else kf[(size_t)c * 8192 + 4096] = 0.f;
    }
  }
}

DI void normmod_phase(const float* __restrict__ xl, const float* __restrict__ xc, const float* __restrict__ gain,
                      const float* __restrict__ mods, int shoff, int scoff, u16* __restrict__ H,
                      const float* __restrict__ part = nullptr, int pgoff = 0, float* __restrict__ xc_out = nullptr) {
  const int lane = TID() & 63;
  int gw = VB() * 4 + (TID() >> 6), stride = NVB() * 4;
  for (int r = gw; r < R_ALL; r += stride) {
    const float* xr = (r < R_LAT) ? xl + (size_t)r * 1024 : xc + (size_t)(r - R_LAT) * 1024;
    int mj = (r < R_LAT) ? (r >> 12) : 8;
    float4 v[4];
    float ss = 0.f;
#pragma unroll
    for (int i = 0; i < 4; ++i) {
      v[i] = *(const float4*)(xr + lane * 4 + 256 * i);
      if (part && r >= R_LAT) {
        int col = lane * 4 + 256 * i;
        float4 g = *(const float4*)(mods + (size_t)8 * 6144 + pgoff + col);
        float4 sum = make_float4(0.f, 0.f, 0.f, 0.f);
#pragma unroll
        for (int ks = 0; ks < 4; ++ks) {
          float4 q = *(const float4*)(part + ((size_t)ks * 2048 + (r - R_LAT)) * 1024 + col);
          sum.x += q.x; sum.y += q.y; sum.z += q.z; sum.w += q.w;
        }
        v[i].x += g.x * sum.x; v[i].y += g.y * sum.y; v[i].z += g.z * sum.z; v[i].w += g.w * sum.w;
        *(float4*)(xc_out + (size_t)(r - R_LAT) * 1024 + col) = v[i];
      }
      ss += v[i].x * v[i].x + v[i].y * v[i].y + v[i].z * v[i].z + v[i].w * v[i].w;
    }
    ss = wave_sum(ss);
    float inv = rsqrtf(ss * (1.f / 1024.f) + EPS);
    const float* mm = mods + (size_t)mj * 6144;
#pragma unroll
    for (int i = 0; i < 4; ++i) {
      int col = lane * 4 + 256 * i;
      float4 g = *(const float4*)(gain + col);
      float4 sc = *(const float4*)(mm + scoff + col);
      float4 sh = *(const float4*)(mm + shoff + col);
      float a0 = v[i].x * inv * g.x * (1.f + sc.x) + sh.x;
      float a1 = v[i].y * inv * g.y * (1.f + sc.y) + sh.y;
      float a2 = v[i].z * inv * g.z * (1.f + sc.z) + sh.z;
      float a3 = v[i].w * inv * g.w * (1.f + sc.w) + sh.w;
      uint2 o; o.x = pack2(a0, a1); o.y = pack2(a2, a3);
      *(uint2*)(H + (size_t)r * 1024 + col) = o;
    }
  }
}

DI void rope8(float* f, float4 c, float4 s) {
  float a, b;
  a = f[0]; b = f[1]; f[0] = a * c.x - b * s.x; f[1] = a * s.x + b * c.x;
  a = f[2]; b = f[3]; f[2] = a * c.y - b * s.y; f[3] = a * s.y + b * c.y;
  a = f[4]; b = f[5]; f[4] = a * c.z - b * s.z; f[5] = a * s.z + b * c.z;
  a = f[6]; b = f[7]; f[6] = a * c.w - b * s.w; f[7] = a * s.w + b * c.w;
}

DI void prep0_job(const P& p, int job, char* smem) {
  const int tid = TID(), lane = tid & 63, wave = tid >> 6;
  const u16* Z = (const u16*)(p.ws + OFF_Z);
  u16* Qa = (u16*)(p.ws + OFF_QA); u16* Ka = (u16*)(p.ws + OFF_KA); u16* VaT = (u16*)(p.ws + OFF_VAT);
  u16* CQ = (u16*)(p.ws + OFF_CQ); u16* CKV = (u16*)(p.ws + OFF_CKV); u16* Kb = (u16*)(p.ws + OFF_KB);
  const float* rope = (const float*)(p.ws + OFF_ROPE);
  u16* vt = (u16*)smem;
  int r0 = job * 32;
  bool isctx = r0 >= R_LAT;
  int b, pos0;
  if (!isctx) { b = r0 >> 12; pos0 = r0 & 4095; } else { b = (r0 - R_LAT) >> 8; pos0 = (r0 - R_LAT) & 255; }
  int kidx0 = isctx ? pos0 : 256 + pos0;
  const float* g_aqn = PIN(I_AQN); const float* g_akn = PIN(I_AKN); const float* g_bqn = PIN(I_BQN); const float* g_bkvn = PIN(I_BKVN);
  __syncthreads();
  for (int rr = 0; rr < 8; ++rr) {
    int tl = wave * 8 + rr;
    int r = r0 + tl, pos = pos0 + tl, kidx = kidx0 + tl;
    int prow = pos >> 6, pcol = pos & 63;
    const u16* zr = Z + (size_t)r * 1440;
    {
      float f[8];
      unpack8(*(const uint4*)(zr + lane * 8), f);
      float ss = 0.f;
#pragma unroll
      for (int j = 0; j < 8; ++j) ss += f[j] * f[j];
      ss += __shfl_xor(ss, 1); ss += __shfl_xor(ss, 2); ss += __shfl_xor(ss, 4);
      float inv = rsqrtf(ss * (1.f / 64.f) + EPS);
      int d0 = (lane & 7) * 8;
#pragma unroll
      for (int j = 0; j < 8; ++j) f[j] = f[j] * inv * g_aqn[d0 + j];
      if (!isctx) {
        int l7 = lane & 7;
        int ti = (l7 < 4) ? (prow * 16 + l7 * 4) : (pcol * 16 + (l7 - 4) * 4);
        rope8(f, *(const float4*)(rope + ti), *(const float4*)(rope + 1024 + ti));
      }
      const float qs = 0.125f * LOG2E;
#pragma unroll
      for (int j = 0; j < 8; ++j) f[j] *= qs;
      int head = lane >> 3;
      *(uint4*)(Qa + ((size_t)(b * 8 + head) * NKEY + kidx) * 64 + d0) = pack8(f);
    }
    if (lane < 16) {
      float f[8];
      unpack8(*(const uint4*)(zr + 896 + lane * 8), f);
      float ss = 0.f;
#pragma unroll
      for (int j = 0; j < 8; ++j) ss += f[j] * f[j];
      ss += __shfl_xor(ss, 1); ss += __shfl_xor(ss, 2); ss += __shfl_xor(ss, 4);
      float inv = rsqrtf(ss * (1.f / 64.f) + EPS);
      int d0 = (lane & 7) * 8;
#pragma unroll
      for (int j = 0; j < 8; ++j) f[j] = f[j] * inv * g_akn[d0 + j];
      if (!isctx) {
        int l7 = lane & 7;
        int ti = (l7 < 4) ? (prow * 16 + l7 * 4) : (pcol * 16 + (l7 - 4) * 4);
        rope8(f, *(const float4*)(rope + ti), *(const float4*)(rope + 1024 + ti));
      }
      int kvh = lane >> 3;
      *(uint4*)(Ka + ((size_t)(b * 2 + kvh) * NKEY + kidx) * 64 + d0) = pack8(f);
    }
    if (lane < 16) {
      uint4 q = *(const uint4*)(zr + 1024 + lane * 8);
      unsigned w[4] = {q.x, q.y, q.z, q.w};
#pragma unroll
      for (int j = 0; j < 4; ++j) {
        vt[(lane * 8 + 2 * j) * 72 + tl] = (u16)(w[j] & 0xffff);
        vt[(lane * 8 + 2 * j + 1) * 72 + tl] = (u16)(w[j] >> 16);
      }
    }
    {
      float f[8];
      float ss = 0.f;
      if (lane < 48) {
        unpack8(*(const uint4*)(zr + 512 + lane * 8), f);
#pragma unroll
        for (int j = 0; j < 8; ++j) ss += f[j] * f[j];
      }
      ss = wave_sum(ss);
      float inv = rsqrtf(ss * (1.f / 384.f) + EPS);
      if (lane < 48) {
#pragma unroll
        for (int j = 0; j < 8; ++j) f[j] = f[j] * inv * g_bqn[lane * 8 + j];
        *(uint4*)(CQ + (size_t)r * 384 + lane * 8) = pack8(f);
      }
    }
    {
      float f[8];
      float ss = 0.f;
      if (lane < 32) {
        unpack8(*(const uint4*)(zr + 1152 + lane * 8), f);
#pragma unroll
        for (int j = 0; j < 8; ++j) ss += f[j] * f[j];
      }
      ss = wave_sum(ss);
      float inv = rsqrtf(ss * (1.f / 256.f) + EPS);
      if (lane < 32) {
#pragma unroll
        for (int j = 0; j < 8; ++j) f[j] = f[j] * inv * g_bkvn[lane * 8 + j];
        *(uint4*)(CKV + (size_t)r * 256 + lane * 8) = pack8(f);
      }
    }
    if (lane < 4) {
      float f[8];
      unpack8(*(const uint4*)(zr + 1408 + lane * 8), f);
      if (!isctx) {
        int ti = (lane < 2) ? (prow * 8 + lane * 4) : (pcol * 8 + (lane - 2) * 4);
        rope8(f, *(const float4*)(rope + 2048 + ti), *(const float4*)(rope + 2560 + ti));
      }
      uint4 o = pack8(f);
#pragma unroll
      for (int h = 0; h < 8; ++h) *(uint4*)(Kb + ((size_t)(b * 8 + h) * NKEY + kidx) * 96 + 64 + lane * 8) = o;
    }
  }
  __syncthreads();
  {
    int d = tid >> 1, half = tid & 1;
    int kvh = d >> 6, dd = d & 63;
    u16* dst = VaT + ((size_t)(b * 2 + kvh) * 64 + dd) * NKEY + kidx0 + half * 16;
    const u16* srcp = vt + d * 72 + half * 16;
#pragma unroll
    for (int j = 0; j < 2; ++j) *(uint4*)(dst + j * 8) = *(const uint4*)(srcp + j * 8);
  }
}

template <int DQ, int MODE>
DI void attn_job(const u16* __restrict__ Qw  , const u16* __restrict__ Kp, const u16* __restrict__ VTp,
                 int ntile, int tlo, int qpos0  , float sink_l2,
                 u16* __restrict__ Obase  , int orow0  , char* smem) {
  constexpr int KSTR = DQ * 2 + 16;
  constexpr int VSTR = 144;
  constexpr int KBYTES = 64 * KSTR, VBYTES = 64 * VSTR;
  constexpr int NKC = DQ / 8;
  constexpr int KCH = 64 * NKC / NT;
  constexpr int NS = DQ / 16;
  const int tid = TID(), lane = tid & 63;
  const int r = lane & 31, h = lane >> 5;
  char* sK = smem;
  char* sV = smem + 2 * KBYTES;
  bf16x8 qf[NS];
#pragma unroll
  for (int s = 0; s < NS; ++s) qf[s] = *(const bf16x8*)(Qw + (size_t)r * DQ + 16 * s + 8 * h);
  f32x16 oacc[2];
#pragma unroll
  for (int i = 0; i < 16; ++i) { oacc[0][i] = 0.f; oacc[1][i] = 0.f; }
  float m = (MODE == 1) ? sink_l2 : 0.f;
  float l = (MODE == 1 && h == 0) ? 1.f : 0.f;
  uint4 rk0, rk1, rk2, rv0, rv1;
  rk2 = make_uint4(0, 0, 0, 0);
  auto tileidx = [&](int i) { return (MODE == 1) ? (i < 4 ? i : tlo + i - 4) : i; };
  const int kr0 = tid / NKC, kc0 = tid - kr0 * NKC;
  const int kr1 = (tid + NT) / NKC, kc1 = (tid + NT) - kr1 * NKC;
  const int kr2 = (tid + 2 * NT) / NKC, kc2 = (tid + 2 * NT) - kr2 * NKC;
  const int vr0 = tid >> 3, vc0 = tid & 7, vr1 = (tid + NT) >> 3;
#define ATT_GLOAD(I)                                                                   \
  {                                                                                    \
    int kt_ = tileidx(I);                                                              \
    rk0 = *(const uint4*)(Kp + (size_t)(kt_ * 64 + kr0) * DQ + kc0 * 8);               \
    rk1 = *(const uint4*)(Kp + (size_t)(kt_ * 64 + kr1) * DQ + kc1 * 8);               \
    if (KCH == 3) rk2 = *(const uint4*)(Kp + (size_t)(kt_ * 64 + kr2) * DQ + kc2 * 8); \
    rv0 = *(const uint4*)(VTp + (size_t)vr0 * NKEY + kt_ * 64 + vc0 * 8);              \
    rv1 = *(const uint4*)(VTp + (size_t)vr1 * NKEY + kt_ * 64 + vc0 * 8);              \
  }
#define ATT_LSTORE(B)                                                        \
  {                                                                          \
    *(uint4*)(sK + (B) * KBYTES + kr0 * KSTR + kc0 * 16) = rk0;              \
    *(uint4*)(sK + (B) * KBYTES + kr1 * KSTR + kc1 * 16) = rk1;              \
    if (KCH == 3) *(uint4*)(sK + (B) * KBYTES + kr2 * KSTR + kc2 * 16) = rk2; \
    *(uint4*)(sV + (B) * VBYTES + vr0 * VSTR + vc0 * 16) = rv0;              \
    *(uint4*)(sV + (B) * VBYTES + vr1 * VSTR + vc0 * 16) = rv1;              \
  }
  __syncthreads();
  ATT_GLOAD(0);
  ATT_LSTORE(0);
  __syncthreads();
  for (int it = 0; it < ntile; ++it) {
    const int buf = it & 1;
    if (it + 1 < ntile) ATT_GLOAD(it + 1);
    const char* kb = sK + buf * KBYTES;
    const char* vb = sV + buf * VBYTES;
    f32x16 sacc[2];
    {
      bf16x8 kf[2][NS];
#pragma unroll
      for (int kt2 = 0; kt2 < 2; ++kt2)
#pragma unroll
        for (int s = 0; s < NS; ++s) kf[kt2][s] = *(const bf16x8*)(kb + (kt2 * 32 + r) * KSTR + (16 * s + 8 * h) * 2);
      __builtin_amdgcn_sched_barrier(0);
#pragma unroll
      for (int kt2 = 0; kt2 < 2; ++kt2) {
#pragma unroll
        for (int i = 0; i < 16; ++i) sacc[kt2][i] = -m;
#pragma unroll
        for (int s = 0; s < NS; ++s) sacc[kt2] = __builtin_amdgcn_mfma_f32_32x32x16_bf16(kf[kt2][s], qf[s], sacc[kt2], 0, 0, 0);
      }
    }
    uint2 vlo[2][2][2], vhi[2][2][2];
#pragma unroll
    for (int kt2 = 0; kt2 < 2; ++kt2)
#pragma unroll
      for (int s2 = 0; s2 < 2; ++s2)
#pragma unroll
        for (int dvt = 0; dvt < 2; ++dvt) {
          const char* vp = vb + (dvt * 32 + r) * VSTR + (kt2 * 32 + 16 * s2 + 4 * h) * 2;
          vlo[kt2][s2][dvt] = *(const uint2*)(vp);
          vhi[kt2][s2][dvt] = *(const uint2*)(vp + 16);
        }
    __builtin_amdgcn_sched_barrier(0);
    if (MODE == 1) {
      int kt = tileidx(it);
      int dbase = kt * 64 + 4 * h - 256 - (qpos0 + r);
      bool lat = kt >= 4;
#pragma unroll
      for (int kt2 = 0; kt2 < 2; ++kt2)
#pragma unroll
        for (int i = 0; i < 16; ++i) {
          int d = dbase + kt2 * 32 + (i & 3) + 8 * (i >> 2);
          bool bad = lat && (d > 128 || d < -128);
          sacc[kt2][i] = bad ? -1e30f : sacc[kt2][i];
        }
    }
    float mx = sacc[0][0];
#pragma unroll
    for (int i = 1; i < 16; ++i) mx = fmaxf(mx, sacc[0][i]);
#pragma unroll
    for (int i = 0; i < 16; ++i) mx = fmaxf(mx, sacc[1][i]);
    mx = fmaxf(mx, __shfl_xor(mx, 32));
    if (__any(mx > 8.f)) {
      float delta = fmaxf(mx, 0.f);
      float alpha = __builtin_amdgcn_exp2f(-delta);
      m += delta;
      l *= alpha;
#pragma unroll
      for (int i = 0; i < 16; ++i) { oacc[0][i] *= alpha; oacc[1][i] *= alpha; sacc[0][i] -= delta; sacc[1][i] -= delta; }
    }
    float rs = 0.f;
#pragma unroll
    for (int kt2 = 0; kt2 < 2; ++kt2)
#pragma unroll
      for (int i = 0; i < 16; ++i) { float pv = __builtin_amdgcn_exp2f(sacc[kt2][i]); sacc[kt2][i] = pv; rs += pv; }
    l += rs;
#pragma unroll
    for (int kt2 = 0; kt2 < 2; ++kt2)
#pragma unroll
      for (int s2 = 0; s2 < 2; ++s2) {
        uint4 pk;
        pk.x = pack2(sacc[kt2][8 * s2 + 0], sacc[kt2][8 * s2 + 1]);
        pk.y = pack2(sacc[kt2][8 * s2 + 2], sacc[kt2][8 * s2 + 3]);
        pk.z = pack2(sacc[kt2][8 * s2 + 4], sacc[kt2][8 * s2 + 5]);
        pk.w = pack2(sacc[kt2][8 * s2 + 6], sacc[kt2][8 * s2 + 7]);
        bf16x8 pf = __builtin_bit_cast(bf16x8, pk);
#pragma unroll
        for (int dvt = 0; dvt < 2; ++dvt) {
          uint2 lo = vlo[kt2][s2][dvt], hi = vhi[kt2][s2][dvt];
          uint4 vv = make_uint4(lo.x, lo.y, hi.x, hi.y);
          bf16x8 vf = __builtin_bit_cast(bf16x8, vv);
          oacc[dvt] = __builtin_amdgcn_mfma_f32_32x32x16_bf16(vf, pf, oacc[dvt], 0, 0, 0);
        }
      }
    if (it + 1 < ntile) ATT_LSTORE(buf ^ 1);
    __syncthreads();
  }
#undef ATT_GLOAD
#undef ATT_LSTORE
  float lt = l + __shfl_xor(l, 32);
  float il = 1.f / lt;
  u16* orow = Obase + (size_t)(orow0 + r) * 1024;
#pragma unroll
  for (int dvt = 0; dvt < 2; ++dvt)
#pragma unroll
    for (int g = 0; g < 4; ++g) {
      uint2 o;
      o.x = pack2(oacc[dvt][4 * g] * il, oacc[dvt][4 * g + 1] * il);
      o.y = pack2(oacc[dvt][4 * g + 2] * il, oacc[dvt][4 * g + 3] * il);
      *(uint2*)(orow + dvt * 32 + 8 * g + 4 * h) = o;
    }
}

DI void prep1_job(const P& p, int job, char* smem) {
  const int tid = TID(), lane = tid & 63, wave = tid >> 6;
  const u16* Z = (const u16*)(p.ws + OFF_Z);
  u16* Qd = (u16*)(p.ws + OFF_QD); u16* Kd = (u16*)(p.ws + OFF_KD); u16* VdT = (u16*)(p.ws + OFF_VDT);
  float* U = (float*)(p.ws + OFF_U); u16* X0 = (u16*)(p.ws + OFF_X0);
  const float* rope = (const float*)(p.ws + OFF_ROPE);
  u16* vt = (u16*)smem;
  float* ut = (float*)(smem + 18432);
  int r0 = job * 64;
  bool isctx = r0 >= R_LAT;
  int b, pos0;
  if (!isctx) { b = r0 >> 12; pos0 = r0 & 4095; } else { b = (r0 - R_LAT) >> 8; pos0 = (r0 - R_LAT) & 255; }
  int kidx0 = isctx ? pos0 : 256 + pos0;
  __syncthreads();
  for (int rr = 0; rr < 16; ++rr) {
    int tl = wave * 16 + rr;
    int r = r0 + tl, pos = pos0 + tl, kidx = kidx0 + tl;
    int prow = pos >> 6, pcol = pos & 63;
    const u16* zr = Z + (size_t)r * 2304;
    int l7 = lane & 7;
    int ti = (l7 < 4) ? (prow * 16 + l7 * 4) : (pcol * 16 + (l7 - 4) * 4);
    if (!isctx) {
      float f[8];
      unpack8(*(const uint4*)(zr + lane * 8), f);
      rope8(f, *(const float4*)(rope + ti), *(const float4*)(rope + 1024 + ti));
      const float qs = 0.125f * LOG2E;
#pragma unroll
      for (int j = 0; j < 8; ++j) f[j] *= qs;
      int head = lane >> 3;
      *(uint4*)(Qd + ((size_t)(b * 8 + head) * NKEY + kidx) * 64 + l7 * 8) = pack8(f);
    }
    if (lane < 16) {
      float f[8];
      unpack8(*(const uint4*)(zr + 2048 + lane * 8), f);
      if (!isctx) rope8(f, *(const float4*)(rope + ti), *(const float4*)(rope + 1024 + ti));
      int kvh = lane >> 3;
      *(uint4*)(Kd + ((size_t)(b * 2 + kvh) * NKEY + kidx) * 64 + l7 * 8) = pack8(f);
      uint4 q = *(const uint4*)(zr + 2176 + lane * 8);
      unsigned w[4] = {q.x, q.y, q.z, q.w};
#pragma unroll
      for (int j = 0; j < 4; ++j) {
        vt[(lane * 8 + 2 * j) * 72 + tl] = (u16)(w[j] & 0xffff);
        vt[(lane * 8 + 2 * j + 1) * 72 + tl] = (u16)(w[j] >> 16);
      }
    }
  }
  __syncthreads();
  {
    int d = tid >> 1, half = tid & 1;
    int kvh = d >> 6, dd = d & 63;
    u16* dst = VdT + ((size_t)(b * 2 + kvh) * 64 + dd) * NKEY + kidx0 + half * 32;
    const u16* srcp = vt + d * 72 + half * 32;
#pragma unroll
    for (int j = 0; j < 4; ++j) *(uint4*)(dst + j * 8) = *(const uint4*)(srcp + j * 8);
  }
  if (isctx) return;
  const float* cw = PIN(I_CCW);
  const float* cb = PIN(I_CCB);
  for (int cc0 = 0; cc0 < 512; cc0 += 128) {
    __syncthreads();
    int c = cc0 + (tid & 63) * 2;
    float wt0[3][2], wt1[3][2], wt2[3][2], wb[3][2];
#pragma unroll
    for (int part = 0; part < 3; ++part)
#pragma unroll
      for (int e = 0; e < 2; ++e) {
        int ch = part * 512 + c + e;
        wt0[part][e] = cw[ch]; wt1[part][e] = cw[1536 + ch]; wt2[part][e] = cw[3072 + ch]; wb[part][e] = cb[ch];
      }
    const int tl0 = (tid >> 6) * 16;
    const u16* zb = Z + (size_t)(r0 + tl0) * 2304 + 512 + c;
    unsigned prv[3], cur[3];
#pragma unroll
    for (int part = 0; part < 3; ++part) {
      cur[part] = *(const unsigned*)(zb + part * 512);
      prv[part] = (pos0 + tl0 > 0) ? *(const unsigned*)(zb + part * 512 - 2304) : 0u;
    }
#pragma unroll 4
    for (int rr = 0; rr < 16; ++rr) {
      int tl = tl0 + rr;
      int r = r0 + tl, pos = pos0 + tl;
      float res[3][2];
#pragma unroll
      for (int part = 0; part < 3; ++part) {
        unsigned nxt = (pos < 4095) ? *(const unsigned*)(zb + part * 512 + (size_t)(rr + 1) * 2304) : 0u;
#pragma unroll
        for (int e = 0; e < 2; ++e) {
          float xc = e ? __uint_as_float(cur[part] & 0xffff0000u) : __uint_as_float(cur[part] << 16);
          float xp = e ? __uint_as_float(prv[part] & 0xffff0000u) : __uint_as_float(prv[part] << 16);
          float xn = e ? __uint_as_float(nxt & 0xffff0000u) : __uint_as_float(nxt << 16);
          res[part][e] = xp * wt0[part][e] + xc * wt1[part][e] + xn * wt2[part][e] + wb[part][e];
        }
        prv[part] = cur[part]; cur[part] = nxt;
      }
      *(unsigned*)(X0 + (size_t)r * 512 + c) = pack2(res[0][0], res[0][1]);
      ut[((tid & 63) * 2) * 65 + tl] = res[2][0] * res[1][0];
      ut[((tid & 63) * 2 + 1) * 65 + tl] = res[2][1] * res[1][1];
    }
    __syncthreads();
    for (int i = 0; i < 32; ++i) {
      int ch = (tid >> 6) + 4 * i;
      U[((size_t)(cc0 + ch) * 8 + b) * 4096 + pos0 + (tid & 63)] = ut[ch * 65 + (tid & 63)];
    }
  }
}

DI float2 cmul(float2 a, float2 b) { return make_float2(a.x * b.x - a.y * b.y, a.x * b.y + a.y * b.x); }
DI float2 cmulc(float2 a, float2 b) { return make_float2(a.x * b.x + a.y * b.y, a.y * b.x - a.x * b.y); }
DI void fft_fwd(float2* sm, const float2* __restrict__ tw) {
  const int tid = TID();
#pragma unroll 1
  for (int m = 4096, sh = 0; m >= 2; m >>= 2, sh += 2) {
    const int hm = m >> 1;
#pragma unroll 1
    for (int hh = 0; hh < 4; ++hh) {
      float2 x0[2], x1[2], x2[2], x3[2];
#pragma unroll
      for (int i = 0; i < 2; ++i) {
        int g = tid + NT * (i + 2 * hh);
        int pp = g & (hm - 1);
        int i0 = ((g - pp) << 2) + pp;
        x0[i] = sm[i0]; x1[i] = sm[i0 + hm]; x2[i] = sm[i0 + m]; x3[i] = sm[i0 + m + hm];
      }
#pragma unroll
      for (int i = 0; i < 2; ++i) {
        int g = tid + NT * (i + 2 * hh);
        int pp = g & (hm - 1);
        int i0 = ((g - pp) << 2) + pp;
        float fr_ = (float)(pp << sh) * (1.f / 8192.f);
        float2 w1 = make_float2(__builtin_amdgcn_cosf(fr_), -__builtin_amdgcn_sinf(fr_));
        float2 w2 = make_float2(__builtin_amdgcn_cosf(2.f * fr_), -__builtin_amdgcn_sinf(2.f * fr_));
        float2 a0 = make_float2(x0[i].x + x2[i].x, x0[i].y + x2[i].y);
        float2 a2 = cmul(make_float2(x0[i].x - x2[i].x, x0[i].y - x2[i].y), w1);
        float2 a1 = make_float2(x1[i].x + x3[i].x, x1[i].y + x3[i].y);
        float2 d13 = cmul(make_float2(x1[i].x - x3[i].x, x1[i].y - x3[i].y), w1);
        float2 a3 = make_float2(d13.y, -d13.x);
        sm[i0] = make_float2(a0.x + a1.x, a0.y + a1.y);
        sm[i0 + hm] = cmul(make_float2(a0.x - a1.x, a0.y - a1.y), w2);
        sm[i0 + m] = make_float2(a2.x + a3.x, a2.y + a3.y);
        sm[i0 + m + hm] = cmul(make_float2(a2.x - a3.x, a2.y - a3.y), w2);
      }
    }
    __syncthreads();
  }
#pragma unroll 4
  for (int i = 0; i < 16; ++i) {
    int j = tid + NT * i;
    float2 a = sm[2 * j], b = sm[2 * j + 1];
    sm[2 * j] = make_float2(a.x + b.x, a.y + b.y);
    sm[2 * j + 1] = make_float2(a.x - b.x, a.y - b.y);
  }
  __syncthreads();
}
DI void fft_inv(float2* sm, const float2* __restrict__ tw) {
  const int tid = TID();
#pragma unroll 4
  for (int i = 0; i < 16; ++i) {
    int j = tid + NT * i;
    float2 a = sm[2 * j], b = sm[2 * j + 1];
    sm[2 * j] = make_float2(a.x + b.x, a.y + b.y);
    sm[2 * j + 1] = make_float2(a.x - b.x, a.y - b.y);
  }
  __syncthreads();
#pragma unroll 1
  for (int m = 4, sh = 10; m <= 4096; m <<= 2, sh -= 2) {
    const int hm = m >> 1;
#pragma unroll 1
    for (int hh = 0; hh < 4; ++hh) {
      float2 x0[2], x1[2], x2[2], x3[2];
#pragma unroll
      for (int i = 0; i < 2; ++i) {
        int g = tid + NT * (i + 2 * hh);
        int pp = g & (hm - 1);
        int i0 = ((g - pp) << 2) + pp;
        x0[i] = sm[i0]; x1[i] = sm[i0 + hm]; x2[i] = sm[i0 + m]; x3[i] = sm[i0 + m + hm];
      }
#pragma unroll
      for (int i = 0; i < 2; ++i) {
        int g = tid + NT * (i + 2 * hh);
        int pp = g & (hm - 1);
        int i0 = ((g - pp) << 2) + pp;
        float fr_ = (float)(pp << sh) * (1.f / 8192.f);
        float2 w1 = make_float2(__builtin_amdgcn_cosf(fr_), -__builtin_amdgcn_sinf(fr_));
        float2 w2 = make_float2(__builtin_amdgcn_cosf(2.f * fr_), -__builtin_amdgcn_sinf(2.f * fr_));
        float2 b1 = cmulc(x1[i], w2), b3 = cmulc(x3[i], w2);
        float2 a0 = make_float2(x0[i].x + b1.x, x0[i].y + b1.y), a1 = make_float2(x0[i].x - b1.x, x0[i].y - b1.y);
        float2 a2 = make_float2(x2[i].x + b3.x, x2[i].y + b3.y), a3 = make_float2(x2[i].x - b3.x, x2[i].y - b3.y);
        float2 c2 = cmulc(a2, w1);
        float2 t3 = cmulc(a3, w1);
        float2 c3 = make_float2(-t3.y, t3.x);
        sm[i0] = make_float2(a0.x + c2.x, a0.y + c2.y);
        sm[i0 + m] = make_float2(a0.x - c2.x, a0.y - c2.y);
        sm[i0 + hm] = make_float2(a1.x + c3.x, a1.y + c3.y);
        sm[i0 + m + hm] = make_float2(a1.x - c3.x, a1.y - c3.y);
      }
    }
    __syncthreads();
  }
}
DI void fft_job(const P& p, int c, char* smem) {
  const int tid = TID();
  float2* sm = (float2*)smem;
  const float2* tw = (const float2*)(p.ws + OFF_TW);
  const float* kf = (const float*)(p.ws + OFF_KF) + (size_t)c * 8192;
  float* U = (float*)(p.ws + OFF_U) + (size_t)c * 8 * 4096;
  float* Yc = (float*)(p.ws + OFF_Y) + (size_t)c * 8 * 4096;
  float bias = PIN(I_CBIAS)[c];
  __syncthreads();
#pragma unroll 4
  for (int i = 0; i < 32; ++i) sm[tid + NT * i] = make_float2(kf[tid + NT * i], 0.f);
  __syncthreads();
  fft_fwd(sm, tw);
  float2 kr[32];
#pragma unroll
  for (int i = 0; i < 32; ++i) { float2 v = sm[tid + NT * i]; kr[i] = make_float2(v.x * (1.f / 8192.f), v.y * (1.f / 8192.f)); }
#pragma unroll 1
  for (int pr = 0; pr < 4; ++pr) {
    float* u0 = U + (size_t)(2 * pr) * 4096;
    float* u1 = u0 + 4096;
    __syncthreads();
#pragma unroll 4
    for (int i = 0; i < 16; ++i) {
      int idx = tid + NT * i;
      sm[idx] = make_float2(u0[idx], u1[idx]);
      sm[idx + 4096] = make_float2(0.f, 0.f);
    }
    __syncthreads();
    fft_fwd(sm, tw);
#pragma unroll
    for (int i = 0; i < 32; ++i) sm[tid + NT * i] = cmul(sm[tid + NT * i], kr[i]);
    __syncthreads();
    fft_inv(sm, tw);
#pragma unroll 4
    for (int i = 0; i < 16; ++i) {
      int idx = tid + NT * i;
      float2 y = sm[idx];
      float a0 = u0[idx], a1 = u1[idx];
      Yc[(size_t)(2 * pr) * 4096 + idx] = y.x + bias * a0;
      Yc[(size_t)(2 * pr + 1) * 4096 + idx] = y.y + bias * a1;
    }
  }
}

DI void gate_job(const P& p, int job, char* smem) {
  const int tid = TID();
  float* yt = (float*)smem;
  const float* Y = (const float*)(p.ws + OFF_Y);
  const u16* X0 = (const u16*)(p.ws + OFF_X0);
  u16* O = (u16*)(p.ws + OFF_H);
  int tile = job >> 2, cc0 = (job & 3) * 128;
  int r0 = tile * 64, b = r0 >> 12, pos0 = r0 & 4095;
  __syncthreads();
  for (int i = 0; i < 32; ++i) {
    int ch = (tid >> 6) + 4 * i;
    yt[ch * 65 + (tid & 63)] = Y[((size_t)(cc0 + ch) * 8 + b) * 4096 + pos0 + (tid & 63)];
  }
  __syncthreads();
#pragma unroll 4
  for (int i = 0; i < 16; ++i) {
    int tl = (tid >> 6) + 4 * i, ch = (tid & 63) * 2;
    unsigned xx = *(const unsigned*)(X0 + (size_t)(r0 + tl) * 512 + cc0 + ch);
    float a0 = __uint_as_float(xx << 16) * yt[ch * 65 + tl];
    float a1 = __uint_as_float(xx & 0xffff0000u) * yt[(ch + 1) * 65 + tl];
    *(unsigned*)(O + (size_t)(r0 + tl) * 1024 + 512 + cc0 + ch) = pack2(a0, a1);
  }
}

DI void gemm_store_phase(const u16* ZR, const u16* A, int lda, int M, const u16* W, int K, int ntn, int N, u16* OUT, int ldo, char* smem) {
  int ntm = M / 256;
  JobIter it = xcd_jobs(ntm * ntn);
  for (int job = it.j; job < it.end; job += it.step) {
    int mt, nt; gemm_decode(job, ntn, mt, nt);
    int m0 = mt * 256, n0 = nt * 256;
    gemm_tile<1>(ZR, A, lda, m0, 0, M, W, K, n0, n0 + 64, n0 + 128, n0 + 192, K, smem, [&](int tl, int fl, f32x4 v) {
      int n = n0 + fl;
      if (n < N) {
        uint2 o; o.x = pack2(v[0], v[1]); o.y = pack2(v[2], v[3]);
        *(uint2*)(OUT + (size_t)(m0 + tl) * ldo + n) = o;
      }
    }, [](int) {});
  }
}
DI void gemm_resid_phase(const u16* ZR, const u16* A, int lda, int M, const u16* W, int K, const float* xin_l,
                         float* xo_l, float* part, const float* mods, int goff, char* smem) {
  JobIter it = xcd_jobs((R_LAT / 256) * 4);
  for (int job = it.j; job < it.end; job += it.step) {
    int mt, nt; gemm_decode(job, 4, mt, nt);
    int m0 = mt * 256, n0 = nt * 256;
    gemm_tile<1>(ZR, A, lda, m0, 0, M, W, K, n0, n0 + 64, n0 + 128, n0 + 192, K, smem, [&](int tl, int fl, f32x4 v) {
      int r = m0 + tl, n = n0 + fl;
      float4 x = *(const float4*)(xin_l + (size_t)r * 1024 + n);
      float4 g = *(const float4*)(mods + (size_t)(r >> 12) * 6144 + goff + n);
      x.x += g.x * v[0]; x.y += g.y * v[1]; x.z += g.z * v[2]; x.w += g.w * v[3];
      *(float4*)(xo_l + (size_t)r * 1024 + n) = x;
    }, [](int) {});
  }
  if (M > R_LAT) {
    const int Ks = K >> 2;
    for (int j = blockIdx.x; j < 128; j += gridDim.x) {
      int mt = (R_LAT / 256) + (j >> 4), nt = (j >> 2) & 3, ks = j & 3;
      int m0 = mt * 256, n0 = nt * 256, k0 = ks * Ks;
      gemm_tile<1>(ZR, A + k0, lda, m0, 0, M, W + k0, K, n0, n0 + 64, n0 + 128, n0 + 192, Ks, smem, [&](int tl, int fl, f32x4 v) {
        int r = m0 + tl - R_LAT, n = n0 + fl;
        *(float4*)(part + ((size_t)ks * 2048 + r) * 1024 + n) = make_float4(v[0], v[1], v[2], v[3]);
      }, [](int) {});
    }
  }
}
DI void ffn_up_phase(const P& p, int layer, int M, char* smem) {
  const u16* H = (const u16*)(p.ws + OFF_H);
  const u16* W = (const u16*)(p.ws + OFF_WUP) + (size_t)layer * 5632 * 1024;
  u16* ACT = (u16*)(p.ws + OFF_ACT);
  const u16* ZR = (const u16*)(p.ws + OFF_ZERO);
  const float* cw = PIN(I_FCW) + (size_t)layer * 3 * 5632;
  const float* cb = PIN(I_FCB) + (size_t)layer * 5632;
  const int tid = PTID();
  int nmt = 8 * 16 + ((M > R_LAT) ? 8 : 0);
  float* EDGE = (float*)(p.ws + OFF_EDGE);
  float* ct = (float*)smem;
  JobIter it = xcd_jobs(nmt * 22);
  for (int job = it.j; job < it.end; job += it.step) {
    int mt, nt; gemm_decode(job, 22, mt, nt);
    int seq0, L, tj;
    int ntj;
    if (mt < 128) { int s_ = mt >> 4; tj = mt & 15; seq0 = s_ * 4096; L = 4096; ntj = 16; }
    else { int s_ = mt - 128; tj = 0; seq0 = R_LAT + s_ * 256; L = 256; ntj = 1; }
    const bool first_t = (tj == 0), last_t = (tj == ntj - 1);
    int tstart = tj * 256;
    int arow0 = seq0 + tstart;
    int n0 = nt * 128;
    gemm_tile<2>(ZR, H, 1024, arow0, seq0, seq0 + L, W, 1024, n0, 2816 + n0, n0 + 64, 2816 + n0 + 64, 1024, smem,
      [&](int tl, int fl, f32x4 v) {
#pragma unroll
        for (int j = 0; j < 4; ++j) ct[((fl & 127) + j) * 257 + tl] = v[j];
      },
      [&](int ph) {
        __syncthreads();
        int j = tid & 63;
        int gc = n0 + ph * 64 + j;
        float wg0 = cw[gc], wg1 = cw[5632 + gc], wg2 = cw[2 * 5632 + gc], bg = cb[gc];
        float wv0 = cw[2816 + gc], wv1 = cw[5632 + 2816 + gc], wv2 = cw[2 * 5632 + 2816 + gc], bv = cb[2816 + gc];
        const float* cg_ = ct + j * 257;
        const float* cv_ = ct + (64 + j) * 257;
        const int i0 = 32 * (tid >> 6);
        if (mt < 128) {
          float* eg = EDGE + (size_t)mt * 4 * 5632 + gc;
          if ((tid >> 6) == 0) { eg[0] = cg_[0]; eg[5632] = cg_[1]; eg[2816] = cv_[0]; eg[5632 + 2816] = cv_[1]; }
          if ((tid >> 6) == 7) { eg[2 * 5632] = cg_[254]; eg[3 * 5632] = cg_[255]; eg[2 * 5632 + 2816] = cv_[254]; eg[3 * 5632 + 2816] = cv_[255]; }
        }
        float gp = (i0 > 0) ? cg_[i0 - 1] : 0.f, gc_ = cg_[i0], vp = (i0 > 0) ? cv_[i0 - 1] : 0.f, vc = cv_[i0];
        u16* outp = ACT + (size_t)(seq0 + tstart + i0) * 2816 + gc;
#pragma unroll 4
        for (int it2 = 0; it2 < 32; ++it2) {
          int i = i0 + it2;
          float gn = (i + 1 <= 255) ? cg_[i + 1] : 0.f, vn = (i + 1 <= 255) ? cv_[i + 1] : 0.f;
          if ((i >= 1 || first_t) && (i <= 254 || last_t)) {
            float g = wg0 * gp + wg1 * gc_ + wg2 * gn + bg;
            float vv = wv0 * vp + wv1 * vc + wv2 * vn + bv;
            float a = g * __builtin_amdgcn_rcpf(1.f + __expf(-g)) * vv;
            outp[(size_t)it2 * 2816] = (u16)(pack2(a, 0.f) & 0xffffu);
          }
          gp = gc_; gc_ = gn; vp = vc; vc = vn;
        }
        __syncthreads();
      });
  }
}

DI void ffn_fix_phase(const P& p, int layer) {
  u16* ACT = (u16*)(p.ws + OFF_ACT);
  const float* EDGE = (const float*)(p.ws + OFF_EDGE);
  const float* cw = PIN(I_FCW) + (size_t)layer * 3 * 5632;
  const float* cb = PIN(I_FCB) + (size_t)layer * 5632;
  const int total = 8 * 15 * 2816;
  for (int w = VB() * NT + TID(); w < total; w += NVB() * NT) {
    int bidx = w / 2816, col = w - bidx * 2816;
    int s_ = bidx / 15, tj = bidx - s_ * 15;
    int mt = s_ * 16 + tj;
    const float* Ea = EDGE + (size_t)mt * 4 * 5632;
    const float* Eb = Ea + 4 * 5632;
    float g254 = Ea[2 * 5632 + col], g255 = Ea[3 * 5632 + col], g0 = Eb[col], g1 = Eb[5632 + col];
    float v254 = Ea[2 * 5632 + 2816 + col], v255 = Ea[3 * 5632 + 2816 + col], v0 = Eb[2816 + col], v1 = Eb[5632 + 2816 + col];
    float wg0 = cw[col], wg1 = cw[5632 + col], wg2 = cw[2 * 5632 + col], bg = cb[col];
    float wv0 = cw[2816 + col], wv1 = cw[5632 + 2816 + col], wv2 = cw[2 * 5632 + 2816 + col], bv = cb[2816 + col];
    size_t row = (size_t)s_ * 4096 + tj * 256 + 255;
    {
      float g = wg0 * g254 + wg1 * g255 + wg2 * g0 + bg;
      float vv = wv0 * v254 + wv1 * v255 + wv2 * v0 + bv;
      ACT[row * 2816 + col] = f2bf(g * __builtin_amdgcn_rcpf(1.f + __expf(-g)) * vv);
    }
    {
      float g = wg0 * g255 + wg1 * g0 + wg2 * g1 + bg;
      float vv = wv0 * v255 + wv1 * v0 + wv2 * v1 + bv;
      ACT[(row + 1) * 2816 + col] = f2bf(g * __builtin_amdgcn_rcpf(1.f + __expf(-g)) * vv);
    }
  }
}

__global__ void __launch_bounds__(PT, 2) mega(P p) {
  extern __shared__ __attribute__((aligned(16))) char smem[];
  char* vsm = smem + VHALF() * VLDS;
  cg::grid_group grid = cg::this_grid();
  __shared__ uint4 xb_words;
  if (threadIdx.x == 0) xb_words = make_uint4(0u, 0u, 0u, 0u);
  __syncthreads();
  XcdBarrier xb = xcd_barrier_post((unsigned*)(p.ws + OFF_BAR), (volatile LAS unsigned*)&xb_words);
  const int tid = TID(), wave = tid >> 6;
  char* ws = p.ws;
  float* mods = (float*)(ws + OFF_MODS);
  float* ctxx = (float*)(ws + OFF_CTXX);
  u16* H = (u16*)(ws + OFF_H);
  u16* Z = (u16*)(ws + OFF_Z);
  const u16* ZR = (const u16*)(ws + OFF_ZERO);

  if (blockIdx.x == 0 && threadIdx.x < 35) ((const float**)(ws + OFF_TAB))[threadIdx.x] = p.in[threadIdx.x];
  {
    constexpr int J_EVIN = 192, J_EVOUT = 128, J_UQ = 36, J_UKV = 32, J_ODIN = 288, J_ODOUT = 128, J_UP = 704, J_DOWN = 352;
    constexpr int J_MODS = 192, J_TAB = 2, J_FILT = 256;
    constexpr int T0 = J_MODS, T1 = T0 + J_TAB, T2 = T1 + J_FILT, T3 = T2 + J_EVIN, T4 = T3 + J_EVOUT, T5 = T4 + J_UQ, T6 = T5 + J_UKV,
                  T7 = T6 + J_ODIN, T8 = T7 + J_ODOUT, T9 = T8 + 2 * J_UP, T10 = T9 + 2 * J_DOWN;
    JobIter it0 = vjobs_plain(T10);
    VJOB_LOOP(it0, job) {
      float* smf = (float*)vsm;
      if (job < T0) mods_job(p, job, smf);
      else if (job < T1) tables_job(p);
      else if (job < T2) filter_job(p, job - T1, smf);
      else if (job < T3) wconv_tile(PIN0(I_EVIN), 1024, 1440, (u16*)(ws + OFF_WEVIN), job - T2, smf);
      else if (job < T4) wconv_tile(PIN0(I_EVOUT), 1024, 1024, (u16*)(ws + OFF_WEVOUT), job - T3, smf);
      else if (job < T5) wconv_tile(PIN0(I_WUQ), 384, 768, (u16*)(ws + OFF_WUQ), job - T4, smf);
      else if (job < T6) wconv_tile(PIN0(I_WUKV), 256, 1024, (u16*)(ws + OFF_WUKV), job - T5, smf);
      else if (job < T7) wconv_tile(PIN0(I_ODIN), 1024, 2304, (u16*)(ws + OFF_WODIN), job - T6, smf);
      else if (job < T8) wconv_tile(PIN0(I_ODOUT), 1024, 1024, (u16*)(ws + OFF_WODOUT), job - T7, smf);
      else if (job < T9) {
        int q = job - T8, l = q / J_UP;
        wconv_tile(PIN0(I_FUP) + (size_t)l * 1024 * 5632, 1024, 5632, (u16*)(ws + OFF_WUP) + (size_t)l * 5632 * 1024, q - l * J_UP, smf);
      } else {
        int q = job - T9, l = q / J_DOWN;
        wconv_tile(PIN0(I_FDOWN) + (size_t)l * 2816 * 1024, 2816, 1024, (u16*)(ws + OFF_WDOWN) + (size_t)l * 1024 * 2816, q - l * J_DOWN, smf);
      }
    }
  }
  if (p.use_cg_sync) grid.sync();
  xcd_barrier(xb);

  normmod_phase(PIN(I_X), PIN(I_CTX), PIN(I_NMIX), mods, 0, 1024, H);
  xcd_barrier(xb);
  gemm_store_phase(ZR, H, 1024, R_ALL, (const u16*)(ws + OFF_WEVIN), 1024, 6, 1440, Z, 1440, smem);
  xcd_barrier(xb);
  { JobIter itp = vjobs_plain(R_ALL / 32); VJOB_LOOP(itp, job) prep0_job(p, job, vsm); }
  xcd_barrier(xb);
  {
    const u16* CQ = (const u16*)(ws + OFF_CQ);
    const u16* CKV = (const u16*)(ws + OFF_CKV);
    u16* Qb = (u16*)(ws + OFF_QB); u16* Kb = (u16*)(ws + OFF_KB); u16* VbT = (u16*)(ws + OFF_VBT);
    const float* rope = (const float*)(ws + OFF_ROPE);
    const int ntm = R_ALL / 256;
    JobIter it = xcd_jobs(ntm * 7);
    for (int job = it.j; job < it.end; job += it.step) {
      int mt, nt; gemm_decode(job, 7, mt, nt);
      int m0 = mt * 256;
      if (nt < 3) {
        int n0 = nt * 256;
        gemm_tile<1>(ZR, CQ, 384, m0, 0, R_ALL, (const u16*)(ws + OFF_WUQ), 384, n0, n0 + 64, n0 + 128, n0 + 192, 384, smem, [&](int tl, int fl, f32x4 v) {
          int r = m0 + tl, f = n0 + fl;
          int head = f / 96, d = f - head * 96;
          int b, pos, kidx;
          bool isctx = r >= R_LAT;
          if (!isctx) { b = r >> 12; pos = r & 4095; kidx = 256 + pos; } else { b = (r - R_LAT) >> 8; pos = (r - R_LAT) & 255; kidx = pos; }
          float x0 = v[0], x1 = v[1], x2 = v[2], x3 = v[3];
          if (d >= 64 && !isctx) {
            int pi = (d - 64) >> 1;
            int prow = pos >> 6, pcol = pos & 63;
            int ti = (pi < 8) ? (prow * 8 + pi) : (pcol * 8 + pi - 8);
            float c0 = rope[2048 + ti], s0 = rope[2560 + ti], c1 = rope[2048 + ti + 1], s1 = rope[2560 + ti + 1];
            float a = x0, bb = x1;
            x0 = a * c0 - bb * s0; x1 = a * s0 + bb * c0;
            a = x2; bb = x3;
            x2 = a * c1 - bb * s1; x3 = a * s1 + bb * c1;
          }
          const float qs = 0.10206207261596575f * LOG2E;
          uint2 o; o.x = pack2(x0 * qs, x1 * qs); o.y = pack2(x2 * qs, x3 * qs);
          *(uint2*)(Qb + ((size_t)(b * 8 + head) * NKEY + kidx) * 96 + d) = o;
        }, [](int) {});
      } else {
        int n0 = (nt - 3) * 256;
        gemm_tile<1>(ZR, CKV, 256, m0, 0, R_ALL, (const u16*)(ws + OFF_WUKV), 256, n0, n0 + 64, n0 + 128, n0 + 192, 256, smem, [&](int tl, int fl, f32x4 v) {
          int r = m0 + tl, f = n0 + fl;
          int head = f >> 7, d = f & 127;
          int b, kidx;
          if (r < R_LAT) { b = r >> 12; kidx = 256 + (r & 4095); } else { b = (r - R_LAT) >> 8; kidx = (r - R_LAT) & 255; }
          if (d < 64) {
            uint2 o; o.x = pack2(v[0], v[1]); o.y = pack2(v[2], v[3]);
            *(uint2*)(Kb + ((size_t)(b * 8 + head) * NKEY + kidx) * 96 + d) = o;
          } else {
            u16* dst = VbT + ((size_t)(b * 8 + head) * 64 + (d - 64)) * NKEY + kidx;
            dst[0] = f2bf(v[0]); dst[NKEY] = f2bf(v[1]); dst[2 * NKEY] = f2bf(v[2]); dst[3 * NKEY] = f2bf(v[3]);
          }
        }, [](int) {});
      }
    }
  }
  xcd_barrier(xb);
  {
    const u16* Qa = (const u16*)(ws + OFF_QA); const u16* Ka = (const u16*)(ws + OFF_KA); const u16* VaT = (const u16*)(ws + OFF_VAT);
    const u16* Qb = (const u16*)(ws + OFF_QB); const u16* Kb = (const u16*)(ws + OFF_KB); const u16* VbT = (const u16*)(ws + OFF_VBT);
    u16* O = H;
    constexpr int JA = 8 * 2 * 136, JB = 8 * 8 * 34;
    JobIter itb = vjobs_xcd(JB);
#pragma unroll 1
    VJOB_LOOP(itb, jb) {
      int xq = jb / 272, cq = jb - xq * 272, bh, qg;
      if (cq < 256) { bh = 8 * xq + (cq >> 5); qg = 2 + (cq & 31); } else { int c2 = cq - 256; bh = 8 * xq + (c2 >> 1); qg = c2 & 1; }
      int b = bh >> 3, head = bh & 7;
      int q0 = qg * 128 + wave * 32;
      int ntile = (qg < 2) ? 4 : 68;
      int orow0 = (q0 < 256) ? (R_LAT + b * 256 + q0) : (b * 4096 + q0 - 256);
      attn_job<96, 0>(Qb + ((size_t)bh * NKEY + q0) * 96, Kb + (size_t)bh * NKEY * 96, VbT + (size_t)bh * 64 * NKEY, ntile, 0, 0, 0.f,
                      O + 512 + head * 64, orow0, vsm);
    }
    JobIter ita = vjobs_xcd(JA);
#pragma unroll 1
    VJOB_LOOP(ita, ja) {
      int xq = ja / 272, cq = ja - xq * 272, bk, qb;
      if (cq < 256) { bk = 2 * xq + (cq >> 7); qb = 8 + (cq & 127); } else { int c2 = cq - 256; bk = 2 * xq + (c2 >> 3); qb = c2 & 7; }
      int b = bk >> 1, kvh = bk & 1;
      int head = kvh * 4 + wave;
      int q0 = qb * 32;
      int ntile = (qb < 8) ? 4 : 68;
      int orow0 = (q0 < 256) ? (R_LAT + b * 256 + q0) : (b * 4096 + q0 - 256);
      attn_job<64, 0>(Qa + ((size_t)(b * 8 + head) * NKEY + q0) * 64, Ka + (size_t)bk * NKEY * 64, VaT + (size_t)bk * 64 * NKEY, ntile, 0, 0,
                      0.f, O + head * 64, orow0, vsm);
    }
  }
  xcd_barrier(xb);
  gemm_resid_phase(ZR, H, 1024, R_ALL, (const u16*)(ws + OFF_WEVOUT), 1024, PIN(I_X), p.out, (float*)(ws + OFF_Y), mods, 2048, smem);
  xcd_barrier(xb);
  normmod_phase(p.out, PIN(I_CTX), PIN(I_NFFN), mods, 3072, 4096, H, (const float*)(ws + OFF_Y), 2048, ctxx);
  xcd_barrier(xb);
  ffn_up_phase(p, 0, R_ALL, smem);
  xcd_barrier(xb);
  ffn_fix_phase(p, 0);
  xcd_barrier(xb);
  gemm_resid_phase(ZR, (const u16*)(ws + OFF_ACT), 2816, R_ALL, (const u16*)(ws + OFF_WDOWN), 2816, p.out, p.out, (float*)(ws + OFF_Y), mods, 5120, smem);
  xcd_barrier(xb);

  const float* mods1 = mods + 9 * 6144;
  normmod_phase(p.out, ctxx, PIN(I_NMIX) + 1024, mods1, 0, 1024, H, (const float*)(ws + OFF_Y), 5120 - 9 * 6144, ctxx);
  xcd_barrier(xb);
  gemm_store_phase(ZR, H, 1024, R_ALL, (const u16*)(ws + OFF_WODIN), 1024, 9, 2304, Z, 2304, smem);
  xcd_barrier(xb);
  { JobIter itp = vjobs_plain(R_ALL / 64); VJOB_LOOP(itp, job) prep1_job(p, job, vsm); }
  xcd_barrier(xb);
  {
    const u16* Qd = (const u16*)(ws + OFF_QD); const u16* Kd = (const u16*)(ws + OFF_KD); const u16* VdT = (const u16*)(ws + OFF_VDT);
    u16* O = H;
    constexpr int JF = 512, JD = 8 * 2 * 128;
    JobIter itm = vjobs_plain(JF + JD);
    VJOB_LOOP(itm, job) {
      if (job < JF) fft_job(p, job, vsm);
      else {
        int jd = job - JF;
        int bk = jd >> 7, qb = jd & 127;
        int b = bk >> 1, kvh = bk & 1;
        int head = kvh * 4 + wave;
        int t0 = qb * 32;
        int klo = 256 + (t0 - 128 > 0 ? t0 - 128 : 0), khi = 256 + (t0 + 159 < 4095 ? t0 + 159 : 4095);
        int tlo = klo >> 6, thi = khi >> 6;
        int ntile = 4 + (thi - tlo + 1);
        float sink = PIN(I_SINK)[head] * LOG2E;
        attn_job<64, 1>(Qd + ((size_t)(b * 8 + head) * NKEY + 256 + t0) * 64, Kd + (size_t)bk * NKEY * 64, VdT + (size_t)bk * 64 * NKEY, ntile,
                        tlo, t0, sink, O + head * 64, b * 4096 + t0, vsm);
      }
    }
  }
  xcd_barrier(xb);
  { JobIter itp = vjobs_plain((R_LAT / 64) * 4); VJOB_LOOP(itp, job) gate_job(p, job, vsm); }
  xcd_barrier(xb);
  gemm_resid_phase(ZR, H, 1024, R_LAT, (const u16*)(ws + OFF_WODOUT), 1024, p.out, p.out, nullptr, mods1, 2048, smem);
  xcd_barrier(xb);
  normmod_phase(p.out, ctxx, PIN(I_NFFN) + 1024, mods1, 3072, 4096, H);
  xcd_barrier(xb);
  ffn_up_phase(p, 1, R_LAT, smem);
  xcd_barrier(xb);
  ffn_fix_phase(p, 1);
  xcd_barrier(xb);
  gemm_resid_phase(ZR, (const u16*)(ws + OFF_ACT), 2816, R_LAT, (const u16*)(ws + OFF_WDOWN) + (size_t)1024 * 2816, 2816, p.out, p.out, nullptr,
                   mods1, 5120, smem);
  xcd_barrier(xb);
  {
    const int lane = tid & 63;
    const float* gain = PIN(I_FNORM);
    for (int r = VB() * 4 + wave; r < R_LAT; r += NVB() * 4) {
      float* xr = p.out + (size_t)r * 1024;
      float4 v[4];
      float ss = 0.f;
#pragma unroll
      for (int i = 0; i < 4; ++i) {
        v[i] = *(const float4*)(xr + lane * 4 + 256 * i);
        ss += v[i].x * v[i].x + v[i].y * v[i].y + v[i].z * v[i].z + v[i].w * v[i].w;
      }
      ss = wave_sum(ss);
      float inv = rsqrtf(ss * (1.f / 1024.f) + EPS);
#pragma unroll
      for (int i = 0; i < 4; ++i) {
        float4 g = *(const float4*)(gain + lane * 4 + 256 * i);
        float4 o = make_float4(v[i].x * inv * g.x, v[i].y * inv * g.y, v[i].z * inv * g.z, v[i].w * inv * g.w);
        *(float4*)(xr + lane * 4 + 256 * i) = o;
      }
    }
  }
}

extern "C" void kernel_launch(void* const* d_in, const int* in_sizes, int n_in, void* d_out, int out_size, void* d_ws, size_t ws_size,
                              hipStream_t stream) {
  static int grid_blocks = 0;
  if (!grid_blocks) {
    int dev = 0, cus = 0, per_cu = 0;
    hipGetDevice(&dev);
    hipDeviceGetAttribute(&cus, hipDeviceAttributeMultiprocessorCount, dev);
    hipFuncSetAttribute((const void*)mega, hipFuncAttributeMaxDynamicSharedMemorySize, LDS_BYTES);
    hipOccupancyMaxActiveBlocksPerMultiprocessor(&per_cu, mega, PT, LDS_BYTES);
    if (per_cu > 1) per_cu = 1;
    if (per_cu < 1) per_cu = 1;
    grid_blocks = cus * per_cu;
  }
  P p{};
  for (int i = 0; i < 35; ++i) p.in[i] = (const float*)d_in[i];
  p.out = (float*)d_out;
  p.ws = (char*)d_ws;
  (void)hipMemsetAsync((char*)d_ws + OFF_BAR, 0, XCD_BAR_WORDS * 4 + 8192, stream);
  void* args[] = {&p};
  hipError_t e = hipLaunchCooperativeKernel((void*)mega, dim3(grid_blocks), dim3(PT), args, LDS_BYTES, stream);
  if (e != hipSuccess) fprintf(stderr, "cooperative launch failed: %s (grid %d)\n", hipGetErrorString(e), grid_blocks);
}
```

```cpp
#include <hip/hip_runtime.h>
#include <hip/hip_cooperative_groups.h>
#include <cstdio>
namespace cg = cooperative_groups;

typedef unsigned short u16;
typedef __attribute__((ext_vector_type(8))) short bf16x8;
typedef __attribute__((ext_vector_type(4))) short s16x4;
typedef __attribute__((ext_vector_type(4))) float f32x4;
typedef __attribute__((ext_vector_type(16))) float f32x16;
typedef __bf16 bf16x2_t __attribute__((ext_vector_type(2)));
typedef float f2_t __attribute__((ext_vector_type(2)));
#define DI __device__ __forceinline__

#define REP_ATT0 1
#define REP_FFNUP 1
#define REP_L1MIX 1
#define REP_DOWN0 1
constexpr int NT = 256;
constexpr int R_LAT = 32768, R_ALL = 34816, DM = 1024;
constexpr int NKEY = 4352;
constexpr float LOG2E = 1.4426950408889634f;
constexpr float EPS = 1e-6f;
constexpr int VLDS = 66560;
constexpr int LDS_BYTES = 2 * VLDS;
constexpr int PT = 512;

constexpr size_t OFF_WEVIN = 0;
constexpr size_t OFF_WEVOUT = OFF_WEVIN + 1536ull * 1024 * 2;
constexpr size_t OFF_WUQ = OFF_WEVOUT + 1024ull * 1024 * 2;
constexpr size_t OFF_WUKV = OFF_WUQ + 768ull * 384 * 2;
constexpr size_t OFF_WODIN = OFF_WUKV + 1024ull * 256 * 2;
constexpr size_t OFF_WODOUT = OFF_WODIN + 2304ull * 1024 * 2;
constexpr size_t OFF_WUP = OFF_WODOUT + 1024ull * 1024 * 2;
constexpr size_t OFF_WDOWN = OFF_WUP + 2ull * 5632 * 1024 * 2;
constexpr size_t OFF_MODS = OFF_WDOWN + 2ull * 1024 * 2816 * 2;
constexpr size_t OFF_ROPE = OFF_MODS + 2ull * 9 * 6144 * 4;
constexpr size_t OFF_TW = OFF_ROPE + 12288;
constexpr size_t OFF_KF = OFF_TW + 4096 * 8;
constexpr size_t OFF_CTXX = OFF_KF + 512ull * 8192 * 4;
constexpr size_t OFF_H = OFF_CTXX + 2048ull * 1024 * 4;
constexpr size_t OFF_Z = OFF_H + (size_t)R_ALL * 1024 * 2;
constexpr size_t OFF_CQ = OFF_Z + (size_t)R_ALL * 1440 * 2;
constexpr size_t OFF_CKV = OFF_CQ + (size_t)R_ALL * 384 * 2;
constexpr size_t OFF_QKV = OFF_Z + (size_t)R_ALL * 2304 * 2;
constexpr size_t OFF_QA = OFF_QKV;
constexpr size_t OFF_KA = OFF_QA + 8ull * 8 * NKEY * 64 * 2;
constexpr size_t OFF_VAT = OFF_KA + 8ull * 2 * NKEY * 64 * 2;
constexpr size_t OFF_QB = OFF_VAT + 8ull * 2 * NKEY * 64 * 2;
constexpr size_t OFF_KB = OFF_QB + 8ull * 8 * NKEY * 96 * 2;
constexpr size_t OFF_VBT = OFF_KB + 8ull * 8 * NKEY * 96 * 2;
constexpr size_t END_L0 = OFF_VBT + 8ull * 8 * NKEY * 64 * 2;
constexpr size_t OFF_QD = OFF_QKV;
constexpr size_t OFF_KD = OFF_QD + 8ull * 8 * NKEY * 64 * 2;
constexpr size_t OFF_VDT = OFF_KD + 8ull * 2 * NKEY * 64 * 2;
constexpr size_t OFF_U = OFF_VDT + 8ull * 2 * NKEY * 64 * 2;
constexpr size_t OFF_X0 = OFF_U + 512ull * 8 * 4096 * 4;
constexpr size_t OFF_Y = OFF_X0 + 32768ull * 512 * 2;
constexpr size_t END_L1 = OFF_Y + 512ull * 8 * 4096 * 4;
constexpr size_t OFF_ACT = OFF_Z;
constexpr size_t WS_NEED = (END_L0 > END_L1 ? END_L0 : END_L1);
constexpr size_t OFF_TAB = WS_NEED;
constexpr size_t OFF_BAR = OFF_TAB + 512;
constexpr size_t OFF_EDGE = OFF_Y + 36ull * 1024 * 1024;
static_assert(OFF_EDGE + 136ull * 4 * 5632 * 4 <= END_L1, "edge");
constexpr size_t OFF_ZERO = OFF_BAR + 3456 * 4;
static_assert(OFF_ZERO + 8192 <= 536870912ull, "workspace too large");
static_assert(OFF_CKV + (size_t)R_ALL * 256 * 2 <= OFF_QKV, "cq/ckv overflow");
static_assert(OFF_ACT + (size_t)R_ALL * 2816 * 2 <= WS_NEED, "act");

struct P {
  const float* in[35];
  float* out;
  char* ws;
  int use_cg_sync;
  int pad_;
};
enum { I_X, I_C, I_CTX, I_CCTX, I_WMOD, I_BMOD, I_NMIX, I_NFFN, I_EVIN, I_EVOUT, I_AQN, I_AKN, I_BQN, I_WUQ, I_BKVN, I_WUKV,
       I_ODIN, I_ODOUT, I_SINK, I_CCW, I_CCB, I_FW1, I_FB1, I_FW2, I_FB2, I_FW3, I_FB3, I_FW4, I_FFREQ, I_CBIAS,
       I_FUP, I_FCW, I_FCB, I_FDOWN, I_FNORM };

#define PIN0(i) (p.in[i])
#define PIN(i) (((const float* const*)(p.ws + OFF_TAB))[i])
DI int PTID() { int t = threadIdx.x; asm volatile("" : "+v"(t)); return t; }
DI int TID() { int t = threadIdx.x & 255; asm volatile("" : "+v"(t)); return t; }
DI int VHALF() { return (int)(threadIdx.x >> 8); }
DI int VB() { return (int)blockIdx.x * 2 + VHALF(); }
DI int NVB() { return (int)gridDim.x * 2; }
DI u16 f2bf(float x) { unsigned u = __float_as_uint(x); u += 0x7fffu + ((u >> 16) & 1u); return (u16)(u >> 16); }
DI float bf2f(u16 h) { return __uint_as_float(((unsigned)h) << 16); }
DI unsigned pack2(float a, float b) { f2_t v = {a, b}; bf16x2_t r = __builtin_convertvector(v, bf16x2_t); return __builtin_bit_cast(unsigned, r); }
DI float wave_sum(float v) { for (int o = 32; o > 0; o >>= 1) v += __shfl_xor(v, o); return v; }
DI void unpack8(uint4 q, float* f) {
  f[0] = __uint_as_float(q.x << 16); f[1] = __uint_as_float(q.x & 0xffff0000u);
  f[2] = __uint_as_float(q.y << 16); f[3] = __uint_as_float(q.y & 0xffff0000u);
  f[4] = __uint_as_float(q.z << 16); f[5] = __uint_as_float(q.z & 0xffff0000u);
  f[6] = __uint_as_float(q.w << 16); f[7] = __uint_as_float(q.w & 0xffff0000u);
}
DI uint4 pack8(const float* f) { uint4 q; q.x = pack2(f[0], f[1]); q.y = pack2(f[2], f[3]); q.z = pack2(f[4], f[5]); q.w = pack2(f[6], f[7]); return q; }


#define XB_TMO      128
#define XB_XCNT(j)  (256  + 64 * (j))
#define XB_XSUB(j)  (1280 + 64 * (j))
#define XB_XGEN(j)  (2304 + 64 * (j))
#define XB_TOP      3328
#define XB_TOPGEN   3392
#define XCD_BAR_WORDS 3456
#define XB_SPIN_CAP (1u << 18)
#define LAS __attribute__((address_space(3)))
DI unsigned xb_ld(unsigned* p) { return __hip_atomic_load(p, __ATOMIC_RELAXED, __HIP_MEMORY_SCOPE_AGENT); }
DI unsigned xb_add(unsigned* p, unsigned v) { return __hip_atomic_fetch_add(p, v, __ATOMIC_RELAXED, __HIP_MEMORY_SCOPE_AGENT); }
DI unsigned xb_xcc_id() { return (unsigned)__builtin_amdgcn_s_getreg((3 << 11) | 20) & 0xFu; }
#define XB_SPIN(cond, bar) do { unsigned _sp = 0; while (cond) { __builtin_amdgcn_s_sleep(1); \
    if ((++_sp & 255u) == 0u) { if (xb_ld(&(bar)[XB_TMO])) break; if (_sp > XB_SPIN_CAP) { atomicAdd(&(bar)[XB_TMO], 1u); break; } } } } while (0)
struct XcdBarrier { unsigned* bar; unsigned x; volatile LAS unsigned* st; };
DI XcdBarrier xcd_barrier_post(unsigned* bar, volatile LAS unsigned* st) {
  XcdBarrier b; b.bar = bar; b.x = xb_xcc_id(); b.st = st;
  if (threadIdx.x == 0) (void)xb_add(&bar[XB_XCNT(b.x)], 1u);
  return b;
}
DI void xcd_barrier_complete(unsigned* bar, unsigned x, unsigned& nloc, unsigned& nx) {
  const unsigned G = gridDim.x * gridDim.y * gridDim.z;
  unsigned sum, cnt, mine, sp = 0u;
  for (;;) {
    sum = 0u; cnt = 0u; mine = 0u;
#pragma unroll
    for (unsigned j = 0; j < 16; ++j) { const unsigned c = xb_ld(&bar[XB_XCNT(j)]); sum += c; cnt += (c > 0u) ? 1u : 0u; mine = (j == x) ? c : mine; }
    if (sum == G) break;
    __builtin_amdgcn_s_sleep(1);
    if ((++sp & 255u) == 0u) { if (xb_ld(&bar[XB_TMO])) break; if (sp > XB_SPIN_CAP) { atomicAdd(&bar[XB_TMO], 1u); break; } }
  }
  nloc = mine > 0u ? mine : 1u; nx = cnt > 0u ? cnt : 1u;
}
DI void xcd_barrier(const XcdBarrier& b) {
  asm volatile("s_waitcnt vmcnt(0)" ::: "memory");
  __syncthreads();
  if (threadIdx.x == 0) {
    unsigned* bar = b.bar;
    __builtin_amdgcn_s_waitcnt(0);
    unsigned nloc = b.st[0], nx = b.st[1];
    if (nloc == 0u) { xcd_barrier_complete(bar, b.x, nloc, nx); b.st[0] = nloc; b.st[1] = nx; }
    const unsigned old = xb_add(&bar[XB_XSUB(b.x)], 1u);
    const unsigned gen = old / nloc;
    if (old + 1u == (gen + 1u) * nloc) {
      __builtin_amdgcn_fence(__ATOMIC_RELEASE, "agent");
      asm volatile("s_waitcnt vmcnt(0)" ::: "memory");
      const unsigned og = xb_add(&bar[XB_TOP], 1u);
      const unsigned tg = og / nx;
      if (og + 1u == (tg + 1u) * nx) xb_add(&bar[XB_TOPGEN], 1u);
      else XB_SPIN(xb_ld(&bar[XB_TOPGEN]) == tg, bar);
      __builtin_amdgcn_fence(__ATOMIC_ACQUIRE, "agent");
      xb_add(&bar[XB_XGEN(b.x)], 1u);
      asm volatile("s_waitcnt vmcnt(0)" ::: "memory");
    } else {
      XB_SPIN(xb_ld(&bar[XB_XGEN(b.x)]) == gen, bar);
      __builtin_amdgcn_fence(__ATOMIC_ACQUIRE, "agent");
      asm volatile("s_waitcnt vmcnt(0)" ::: "memory");
    }
  }
  __syncthreads();
}

struct JobIter { int j, end, step, n; };
DI JobIter vjobs_plain(int J) {
  JobIter it; int b2 = (int)blockIdx.x * 2, nvb = NVB();
  it.j = b2 + VHALF(); it.end = J; it.step = nvb; it.n = (J > b2) ? (J - b2 + nvb - 1) / nvb : 0;
  return it;
}
DI JobIter vjobs_xcd(int J) {
  int b = blockIdx.x, nb = gridDim.x;
  if (nb & 7) return vjobs_plain(J);
  JobIter it;
  int x = b & 7, r0 = (b >> 3) * 2, chunk = (J + 7) >> 3;
  int lo = x * chunk, hi = lo + chunk < J ? lo + chunk : J;
  it.step = (nb >> 3) * 2; it.j = lo + r0 + VHALF(); it.end = hi;
  it.n = (hi - lo > r0) ? (hi - lo - r0 + it.step - 1) / it.step : 0;
  return it;
}
#define VJOB_LOOP(it, job) for (int t_ = 0, j_ = (it).j, job = 0; t_ < (it).n && ((job = j_ < (it).end ? j_ : (it).end - 1), true); ++t_, j_ += (it).step)
DI JobIter xcd_jobs(int J) {
  int b = blockIdx.x, nb = gridDim.x;
  JobIter it; it.n = 0;
  if ((nb & 7) == 0) {
    int x = b & 7, r = b >> 3, chunk = (J + 7) >> 3;
    int lo = x * chunk, hi = lo + chunk < J ? lo + chunk : J;
    it.j = lo + r; it.end = hi; it.step = nb >> 3;
  } else { it.j = b; it.end = J; it.step = nb; }
  return it;
}
DI void gemm_decode(int j, int ntn, int& mt, int& nt) { int g = j / (8 * ntn); int rem = j - g * 8 * ntn; nt = rem >> 3; mt = g * 8 + (rem & 7); }

DI int lds_off(int row, int c) { return row * 128 + ((c ^ ((row >> 1) & 7)) << 4); }

#define RAW_BARRIER() do { asm volatile("s_waitcnt lgkmcnt(0)" ::: "memory"); __builtin_amdgcn_s_barrier(); } while (0)
template <int NPASS, class Epi, class Post>
DI void gemm_tile(const u16* __restrict__ zero_row, const u16* __restrict__ A, int lda, int arow0, int alo, int ahi,
                  const u16* __restrict__ W, int ldw, int wq0, int wq1, int wq2, int wq3, int K, char* smem, Epi epi, Post post) {
  const int tid = PTID(), lane = tid & 63, wave = tid >> 6;
  const int wm = wave & 1, wn = wave >> 1;
  f32x4 acc[4][8];
#pragma unroll
  for (int i = 0; i < 4; ++i)
#pragma unroll
    for (int j = 0; j < 8; ++j) acc[i][j] = (f32x4){0.f, 0.f, 0.f, 0.f};
  const int nk = K >> 6;
  const int r8 = lane >> 3, cs = (lane & 7) ^ (((lane >> 4) & 3) + 4 * (wave & 1));
  const u16* pa[4];
#pragma unroll
  for (int i = 0; i < 4; ++i) {
    int r = arow0 + 8 * wave + r8 + 64 * i; bool v = (r >= alo && r < ahi);
    pa[i] = (v ? A + (size_t)r * lda : zero_row) + cs * 8;
  }
  const u16* pw0 = W + (size_t)(wq0 + 8 * wave + r8) * ldw + cs * 8;
  const u16* pw1 = W + (size_t)(wq1 + 8 * wave + r8) * ldw + cs * 8;
  const u16* pw2 = W + (size_t)(wq2 + 8 * wave + r8) * ldw + cs * 8;
  const u16* pw3 = W + (size_t)(wq3 + 8 * wave + r8) * ldw + cs * 8;
  char* dmab = smem + wave * 1024;
#define GLDS(KT)                                                                                         \
  {                                                                                                      \
    int ko_ = (KT) * 64; char* d_ = dmab + ((KT) & 1) * 65536;                                           \
    __builtin_amdgcn_global_load_lds((const unsigned*)(pa[0] + ko_), (unsigned*)(d_), 16, 0, 0);         \
    __builtin_amdgcn_global_load_lds((const unsigned*)(pa[1] + ko_), (unsigned*)(d_ + 8192), 16, 0, 0);  \
    __builtin_amdgcn_global_load_lds((const unsigned*)(pa[2] + ko_), (unsigned*)(d_ + 16384), 16, 0, 0); \
    __builtin_amdgcn_global_load_lds((const unsigned*)(pa[3] + ko_), (unsigned*)(d_ + 24576), 16, 0, 0); \
    __builtin_amdgcn_global_load_lds((const unsigned*)(pw0 + ko_), (unsigned*)(d_ + 32768), 16, 0, 0);   \
    __builtin_amdgcn_global_load_lds((const unsigned*)(pw1 + ko_), (unsigned*)(d_ + 40960), 16, 0, 0);   \
    __builtin_amdgcn_global_load_lds((const unsigned*)(pw2 + ko_), (unsigned*)(d_ + 49152), 16, 0, 0);   \
    __builtin_amdgcn_global_load_lds((const unsigned*)(pw3 + ko_), (unsigned*)(d_ + 57344), 16, 0, 0);   \
  }
  const int fro = lds_off(lane & 15, lane >> 4);
  __syncthreads();
  GLDS(0);
  GLDS(1);
  asm volatile("s_waitcnt vmcnt(8)" ::: "memory");
  RAW_BARRIER();
#define RD4(dst, base, first) { _Pragma("unroll") for (int i_ = 0; i_ < 4; ++i_) dst[i_] = *(const bf16x8*)((base) + ((first) + i_) * 2048); }
#define MM16(fw, fa, mbase) { _Pragma("unroll") for (int mi_ = 0; mi_ < 4; ++mi_) _Pragma("unroll") for (int ni_ = 0; ni_ < 4; ++ni_) \
      acc[ni_][(mbase) + mi_] = __builtin_amdgcn_mfma_f32_16x16x32_bf16(fw[ni_], fa[mi_], acc[ni_][(mbase) + mi_], 0, 0, 0); }
#pragma unroll 1
  for (int kt = 0; kt < nk; ++kt) {
    const char* st_ = smem + (kt & 1) * 65536;
    const char* a0_ = st_ + wm * 16384 + fro;
    const char* w0_ = st_ + 32768 + wn * 8192 + fro;
    const char* a1_ = st_ + wm * 16384 + (fro ^ 64);
    const char* w1_ = st_ + 32768 + wn * 8192 + (fro ^ 64);
    bf16x8 fwA[4], fwB[4], faA[4], faB[4];
    RD4(fwA, w0_, 0); RD4(faA, a0_, 0);
    __builtin_amdgcn_sched_barrier(0);
    RD4(faB, a0_, 4); RD4(fwB, w1_, 0);
    __builtin_amdgcn_sched_barrier(0);
    MM16(fwA, faA, 0);
    RD4(faA, a1_, 0);
    MM16(fwA, faB, 4);
    RD4(faB, a1_, 4);
    MM16(fwB, faA, 0);
    MM16(fwB, faB, 4);
    __builtin_amdgcn_sched_barrier(0);
    asm volatile("s_waitcnt vmcnt(0)" ::: "memory");
    RAW_BARRIER();
    if (kt + 2 < nk) GLDS(kt + 2);
  }
#undef GLDS
#undef RD4
#undef MM16
#pragma unroll
  for (int ph = 0; ph < NPASS; ++ph) {
    if (NPASS == 1 || (wn >> 1) == ph) {
#pragma unroll
      for (int ni = 0; ni < 4; ++ni)
#pragma unroll
        for (int mi = 0; mi < 8; ++mi)
          epi(wm * 128 + mi * 16 + (lane & 15), wn * 64 + ni * 16 + (lane >> 4) * 4, acc[ni][mi]);
    }
    post(ph);
  }
}

DI void wconv_tile(const float* __restrict__ src, int K, int N, u16* __restrict__ dst, int tile, float* sm) {
  const int tid = TID();
  int nkt = K >> 6;
  int tn = tile / nkt, tk = tile - tn * nkt;
  int n0 = tn * 128, k0 = tk * 64;
  float v[32];
  const int n = n0 + (tid & 63);
#pragma unroll
  for (int i = 0; i < 16; ++i) {
    int kk = (tid >> 6) + 4 * i;
    const float* sp = src + (size_t)(k0 + kk) * N + n;
    v[2 * i] = (n < N) ? sp[0] : 0.f;
    v[2 * i + 1] = (n + 64 < N) ? sp[64] : 0.f;
  }
  __syncthreads();
#pragma unroll
  for (int i = 0; i < 16; ++i) {
    int kk = (tid >> 6) + 4 * i;
    sm[kk * 65 + (tid & 63)] = v[2 * i];
    sm[4160 + kk * 65 + (tid & 63)] = v[2 * i + 1];
  }
  __syncthreads();
#pragma unroll 8
  for (int i = 0; i < 32; ++i) {
    int nn = (tid >> 6) + 4 * i;
    float x = sm[(nn >> 6) * 4160 + (tid & 63) * 65 + (nn & 63)];
    dst[(size_t)(n0 + nn) * K + k0 + (tid & 63)] = (u16)(pack2(x, 0.f) & 0xffffu);
  }
}

DI void mods_job(const P& p, int job, float* sm) {
  const int tid = TID();
  int l = job / 192, cg_ = job - l * 192;
  float* sc = sm;
  float* red = sm + 9 * 1024;
  __syncthreads();
  const float* cvec = PIN0(I_C); const float* ccv = PIN0(I_CCTX);
  for (int i = tid; i < 9 * 1024; i += NT) {
    int j = i >> 10, k = i & 1023;
    float v = (j < 8) ? cvec[j * 1024 + k] : ccv[k];
    sc[i] = v / (1.f + __expf(-v));
  }
  __syncthreads();
  int col = cg_ * 32 + (tid & 31), ks = tid >> 5;
  float acc[9];
#pragma unroll
  for (int j = 0; j < 9; ++j) acc[j] = 0.f;
  const float* w = PIN0(I_WMOD) + (size_t)l * 1024 * 6144 + col;
#pragma unroll 2
  for (int k = ks * 128; k < ks * 128 + 128; k += 4) {
    float w0 = w[(size_t)k * 6144], w1 = w[(size_t)(k + 1) * 6144], w2 = w[(size_t)(k + 2) * 6144], w3 = w[(size_t)(k + 3) * 6144];
#pragma unroll
    for (int j = 0; j < 9; ++j) {
      float4 sv = *(const float4*)(sc + j * 1024 + k);
      acc[j] += sv.x * w0 + sv.y * w1 + sv.z * w2 + sv.w * w3;
    }
  }
#pragma unroll
  for (int j = 0; j < 9; ++j) red[(ks * 9 + j) * 32 + (tid & 31)] = acc[j];
  __syncthreads();
  float* mods = (float*)(p.ws + OFF_MODS);
  for (int i = tid; i < 9 * 32; i += NT) {
    int j = i >> 5, cc = i & 31;
    float s = 0.f;
#pragma unroll
    for (int q = 0; q < 8; ++q) s += red[(q * 9 + j) * 32 + cc];
    int c2 = cg_ * 32 + cc;
    mods[((size_t)l * 9 + j) * 6144 + c2] = s + PIN0(I_BMOD)[l * 6144 + c2];
  }
}

DI void tables_job(const P& p) {
  const int tid = TID();
  float* rope = (float*)(p.ws + OFF_ROPE);
  for (int i = tid; i < 1024; i += NT) {
    int pos = i >> 4, f = i & 15;
    float invf = powf(10000.f, -(float)f / 16.f);
    float ang = (float)pos * invf, s, c;
    sincosf(ang, &s, &c);
    rope[i] = c; rope[1024 + i] = s;
  }
  for (int i = tid; i < 512; i += NT) {
    int pos = i >> 3, f = i & 7;
    float invf = powf(10000.f, -(float)f / 8.f);
    float ang = (float)pos * invf, s, c;
    sincosf(ang, &s, &c);
    rope[2048 + i] = c; rope[2560 + i] = s;
  }
  float2* tw = (float2*)(p.ws + OFF_TW);
  for (int i = tid; i < 4096; i += NT) {
    float s, c;
    sincospif((float)i / 4096.f, &s, &c);
    tw[i] = make_float2(c, -s);
  }
}

DI void filter_job(const P& p, int job, float* sm) {
  const int tid = TID();
  float* ha = sm;
  float* hb = sm + 1024;
  float* zf = sm + 2048;
  __syncthreads();
  if (tid < 16) {
    int pos = job * 16 + tid;
    float t = (float)pos / 4095.f;
    float w = 6.283185307179586f * (float)pos / 4096.f;
    float s0, c0, s1, c1;
    sincosf(1e-4f * w, &s0, &c0);
    sincosf(w, &s1, &c1);
    zf[tid * 8 + 0] = t; zf[tid * 8 + 1] = c0; zf[tid * 8 + 2] = c1; zf[tid * 8 + 3] = -s0; zf[tid * 8 + 4] = -s1;
  }
  __syncthreads();
  const float* fr = PIN0(I_FFREQ);
  const float* fw1 = PIN0(I_FW1); const float* fb1 = PIN0(I_FB1); const float* fw2 = PIN0(I_FW2); const float* fb2 = PIN0(I_FB2);
  const float* fw3 = PIN0(I_FW3); const float* fb3 = PIN0(I_FB3); const float* fw4 = PIN0(I_FW4);
  for (int i = tid; i < 1024; i += NT) {
    int pp = i >> 6, j = i & 63;
    float a = fb1[j];
#pragma unroll
    for (int e = 0; e < 5; ++e) a += zf[pp * 8 + e] * fw1[e * 64 + j];
    ha[i] = sinf(fr[j] * a);
  }
  __syncthreads();
  for (int i = tid; i < 1024; i += NT) {
    int pp = i >> 6, j = i & 63;
    float a = fb2[j];
#pragma unroll 4
    for (int e = 0; e < 64; e += 4) {
      float4 hv = *(const float4*)(ha + pp * 64 + e);
      a += hv.x * fw2[e * 64 + j] + hv.y * fw2[(e + 1) * 64 + j] + hv.z * fw2[(e + 2) * 64 + j] + hv.w * fw2[(e + 3) * 64 + j];
    }
    hb[i] = sinf(fr[64 + j] * a);
  }
  __syncthreads();
  for (int i = tid; i < 1024; i += NT) {
    int pp = i >> 6, j = i & 63;
    float a = fb3[j];
#pragma unroll 4
    for (int e = 0; e < 64; e += 4) {
      float4 hv = *(const float4*)(hb + pp * 64 + e);
      a += hv.x * fw3[e * 64 + j] + hv.y * fw3[(e + 1) * 64 + j] + hv.z * fw3[(e + 2) * 64 + j] + hv.w * fw3[(e + 3) * 64 + j];
    }
    ha[i] = sinf(fr[128 + j] * a);
  }
  __syncthreads();
  float* kf = (float*)(p.ws + OFF_KF);
#pragma unroll 1
  for (int q = 0; q < 4; ++q) {
    int o = tid + 256 * q;
    float acc[16];
#pragma unroll
    for (int pp = 0; pp < 16; ++pp) acc[pp] = 0.f;
#pragma unroll 1
    for (int e = 0; e < 64; e += 4) {
      float w0 = fw4[e * 1024 + o], w1 = fw4[(e + 1) * 1024 + o], w2 = fw4[(e + 2) * 1024 + o], w3 = fw4[(e + 3) * 1024 + o];
#pragma unroll
      for (int pp = 0; pp < 16; ++pp) {
        float4 hv = *(const float4*)(ha + pp * 64 + e);
        acc[pp] += hv.x * w0 + hv.y * w1 + hv.z * w2 + hv.w * w3;
      }
    }
    int c = o & 511, dir = o >> 9;
    const float mind = -3.0701134573253945f, maxd = -15.350567286626973f;
    float delta = fabsf(mind + (maxd - mind) * (float)c / 511.f);
#pragma unroll
    for (int pp = 0; pp < 16; ++pp) {
      int pos = job * 16 + pp;
      float t = (float)pos / 4095.f;
      float v = acc[pp] * __expf(-t * delta);
      if (dir == 0) kf[(size_t)c * 8192 + pos] = v;
      else if (pos > 0) kf[(size_t)c * 8192 + 8192 - pos] = v;
      else kf[(size_t)c * 8192 + 4096] = 0.f;
    }
  }
}

DI void normmod_phase(const float* __restrict__ xl, const float* __restrict__ xc, const float* __restrict__ gain,
                      const float* __restrict__ mods, int shoff, int scoff, u16* __restrict__ H,
                      const float* __restrict__ part = nullptr, int pgoff = 0, float* __restrict__ xc_out = nullptr) {
  const int lane = TID() & 63;
  int gw = VB() * 4 + (TID() >> 6), stride = NVB() * 4;
  for (int r = gw; r < R_ALL; r += stride) {
    const float* xr = (r < R_LAT) ? xl + (size_t)r * 1024 : xc + (size_t)(r - R_LAT) * 1024;
    int mj = (r < R_LAT) ? (r >> 12) : 8;
    float4 v[4];
    float ss = 0.f;
#pragma unroll
    for (int i = 0; i < 4; ++i) {
      v[i] = *(const float4*)(xr + lane * 4 + 256 * i);
      if (part && r >= R_LAT) {
        int col = lane * 4 + 256 * i;
        float4 g = *(const float4*)(mods + (size_t)8 * 6144 + pgoff + col);
        float4 sum = make_float4(0.f, 0.f, 0.f, 0.f);
#pragma unroll
        for (int ks = 0; ks < 4; ++ks) {
          float4 q = *(const float4*)(part + ((size_t)ks * 2048 + (r - R_LAT)) * 1024 + col);
          sum.x += q.x; sum.y += q.y; sum.z += q.z; sum.w += q.w;
        }
        v[i].x += g.x * sum.x; v[i].y += g.y * sum.y; v[i].z += g.z * sum.z; v[i].w += g.w * sum.w;
        *(float4*)(xc_out + (size_t)(r - R_LAT) * 1024 + col) = v[i];
      }
      ss += v[i].x * v[i].x + v[i].y * v[i].y + v[i].z * v[i].z + v[i].w * v[i].w;
    }
    ss = wave_sum(ss);
    float inv = rsqrtf(ss * (1.f / 1024.f) + EPS);
    const float* mm = mods + (size_t)mj * 6144;
#pragma unroll
    for (int i = 0; i < 4; ++i) {
      int col = lane * 4 + 256 * i;
      float4 g = *(const float4*)(gain + col);
      float4 sc = *(const float4*)(mm + scoff + col);
      float4 sh = *(const float4*)(mm + shoff + col);
      float a0 = v[i].x * inv * g.x * (1.f + sc.x) + sh.x;
      float a1 = v[i].y * inv * g.y * (1.f + sc.y) + sh.y;
      float a2 = v[i].z * inv * g.z * (1.f + sc.z) + sh.z;
      float a3 = v[i].w * inv * g.w * (1.f + sc.w) + sh.w;
      uint2 o; o.x = pack2(a0, a1); o.y = pack2(a2, a3);
      *(uint2*)(H + (size_t)r * 1024 + col) = o;
    }
  }
}

DI void rope8(float* f, float4 c, float4 s) {
  float a, b;
  a = f[0]; b = f[1]; f[0] = a * c.x - b * s.x; f[1] = a * s.x + b * c.x;
  a = f[2]; b = f[3]; f[2] = a * c.y - b * s.y; f[3] = a * s.y + b * c.y;
  a = f[4]; b = f[5]; f[4] = a * c.z - b * s.z; f[5] = a * s.z + b * c.z;
  a = f[6]; b = f[7]; f[6] = a * c.w - b * s.w; f[7] = a * s.w + b * c.w;
}

DI void prep0_job(const P& p, int job, char* smem) {
  const int tid = TID(), lane = tid & 63, wave = tid >> 6;
  const u16* Z = (const u16*)(p.ws + OFF_Z);
  u16* Qa = (u16*)(p.ws + OFF_QA); u16* Ka = (u16*)(p.ws + OFF_KA); u16* VaT = (u16*)(p.ws + OFF_VAT);
  u16* CQ = (u16*)(p.ws + OFF_CQ); u16* CKV = (u16*)(p.ws + OFF_CKV); u16* Kb = (u16*)(p.ws + OFF_KB);
  const float* rope = (const float*)(p.ws + OFF_ROPE);
  u16* vt = (u16*)smem;
  int r0 = job * 32;
  bool isctx = r0 >= R_LAT;
  int b, pos0;
  if (!isctx) { b = r0 >> 12; pos0 = r0 & 4095; } else { b = (r0 - R_LAT) >> 8; pos0 = (r0 - R_LAT) & 255; }
  int kidx0 = isctx ? pos0 : 256 + pos0;
  const float* g_aqn = PIN(I_AQN); const float* g_akn = PIN(I_AKN); const float* g_bqn = PIN(I_BQN); const float* g_bkvn = PIN(I_BKVN);
  __syncthreads();
  for (int rr = 0; rr < 8; ++rr) {
    int tl = wave * 8 + rr;
    int r = r0 + tl, pos = pos0 + tl, kidx = kidx0 + tl;
    int prow = pos >> 6, pcol = pos & 63;
    const u16* zr = Z + (size_t)r * 1440;
    {
      float f[8];
      unpack8(*(const uint4*)(zr + lane * 8), f);
      float ss = 0.f;
#pragma unroll
      for (int j = 0; j < 8; ++j) ss += f[j] * f[j];
      ss += __shfl_xor(ss, 1); ss += __shfl_xor(ss, 2); ss += __shfl_xor(ss, 4);
      float inv = rsqrtf(ss * (1.f / 64.f) + EPS);
      int d0 = (lane & 7) * 8;
#pragma unroll
      for (int j = 0; j < 8; ++j) f[j] = f[j] * inv * g_aqn[d0 + j];
      if (!isctx) {
        int l7 = lane & 7;
        int ti = (l7 < 4) ? (prow * 16 + l7 * 4) : (pcol * 16 + (l7 - 4) * 4);
        rope8(f, *(const float4*)(rope + ti), *(const float4*)(rope + 1024 + ti));
      }
      const float qs = 0.125f * LOG2E;
#pragma unroll
      for (int j = 0; j < 8; ++j) f[j] *= qs;
      int head = lane >> 3;
      *(uint4*)(Qa + ((size_t)(b * 8 + head) * NKEY + kidx) * 64 + d0) = pack8(f);
    }
    if (lane < 16) {
      float f[8];
      unpack8(*(const uint4*)(zr + 896 + lane * 8), f);
      float ss = 0.f;
#pragma unroll
      for (int j = 0; j < 8; ++j) ss += f[j] * f[j];
      ss += __shfl_xor(ss, 1); ss += __shfl_xor(ss, 2); ss += __shfl_xor(ss, 4);
      float inv = rsqrtf(ss * (1.f / 64.f) + EPS);
      int d0 = (lane & 7) * 8;
#pragma unroll
      for (int j = 0; j < 8; ++j) f[j] = f[j] * inv * g_akn[d0 + j];
      if (!isctx) {
        int l7 = lane & 7;
        int ti = (l7 < 4) ? (prow * 16 + l7 * 4) : (pcol * 16 + (l7 - 4) * 4);
        rope8(f, *(const float4*)(rope + ti), *(const float4*)(rope + 1024 + ti));
      }
      int kvh = lane >> 3;
      *(uint4*)(Ka + ((size_t)(b * 2 + kvh) * NKEY + kidx) * 64 + d0) = pack8(f);
    }
    if (lane < 16) {
      uint4 q = *(const uint4*)(zr + 1024 + lane * 8);
      unsigned w[4] = {q.x, q.y, q.z, q.w};
#pragma unroll
      for (int j = 0; j < 4; ++j) {
        vt[(lane * 8 + 2 * j) * 72 + tl] = (u16)(w[j] & 0xffff);
        vt[(lane * 8 + 2 * j + 1) * 72 + tl] = (u16)(w[j] >> 16);
      }
    }
    {
      float f[8];
      float ss = 0.f;
      if (lane < 48) {
        unpack8(*(const uint4*)(zr + 512 + lane * 8), f);
#pragma unroll
        for (int j = 0; j < 8; ++j) ss += f[j] * f[j];
      }
      ss = wave_sum(ss);
      float inv = rsqrtf(ss * (1.f / 384.f) + EPS);
      if (lane < 48) {
#pragma unroll
        for (int j = 0; j < 8; ++j) f[j] = f[j] * inv * g_bqn[lane * 8 + j];
        *(uint4*)(CQ + (size_t)r * 384 + lane * 8) = pack8(f);
      }
    }
    {
      float f[8];
      float ss = 0.f;
      if (lane < 32) {
        unpack8(*(const uint4*)(zr + 1152 + lane * 8), f);
#pragma unroll
        for (int j = 0; j < 8; ++j) ss += f[j] * f[j];
      }
      ss = wave_sum(ss);
      float inv = rsqrtf(ss * (1.f / 256.f) + EPS);
      if (lane < 32) {
#pragma unroll
        for (int j = 0; j < 8; ++j) f[j] = f[j] * inv * g_bkvn[lane * 8 + j];
        *(uint4*)(CKV + (size_t)r * 256 + lane * 8) = pack8(f);
      }
    }
    if (lane < 4) {
      float f[8];
      unpack8(*(const uint4*)(zr + 1408 + lane * 8), f);
      if (!isctx) {
        int ti = (lane < 2) ? (prow * 8 + lane * 4) : (pcol * 8 + (lane - 2) * 4);
        rope8(f, *(const float4*)(rope + 2048 + ti), *(const float4*)(rope + 2560 + ti));
      }
      uint4 o = pack8(f);
#pragma unroll
      for (int h = 0; h < 8; ++h) *(uint4*)(Kb + ((size_t)(b * 8 + h) * NKEY + kidx) * 96 + 64 + lane * 8) = o;
    }
  }
  __syncthreads();
  {
    int d = tid >> 1, half = tid & 1;
    int kvh = d >> 6, dd = d & 63;
    u16* dst = VaT + ((size_t)(b * 2 + kvh) * 64 + dd) * NKEY + kidx0 + half * 16;
    const u16* srcp = vt + d * 72 + half * 16;
#pragma unroll
    for (int j = 0; j < 2; ++j) *(uint4*)(dst + j * 8) = *(const uint4*)(srcp + j * 8);
  }
}

template <int DQ, int MODE>
DI void attn_job(const u16* __restrict__ Qw  , const u16* __restrict__ Kp, const u16* __restrict__ VTp,
                 int ntile, int tlo, int qpos0  , float sink_l2,
                 u16* __restrict__ Obase  , int orow0  , char* smem) {
  constexpr int KSTR = DQ * 2 + 16;
  constexpr int VSTR = 144;
  constexpr int KBYTES = 64 * KSTR, VBYTES = 64 * VSTR;
  constexpr int NKC = DQ / 8;
  constexpr int KCH = 64 * NKC / NT;
  constexpr int NS = DQ / 16;
  const int tid = TID(), lane = tid & 63;
  const int r = lane & 31, h = lane >> 5;
  char* sK = smem;
  char* sV = smem + 2 * KBYTES;
  bf16x8 qf[NS];
#pragma unroll
  for (int s = 0; s < NS; ++s) qf[s] = *(const bf16x8*)(Qw + (size_t)r * DQ + 16 * s + 8 * h);
  f32x16 oacc[2];
#pragma unroll
  for (int i = 0; i < 16; ++i) { oacc[0][i] = 0.f; oacc[1][i] = 0.f; }
  float m = (MODE == 1) ? sink_l2 : 0.f;
  float l = (MODE == 1 && h == 0) ? 1.f : 0.f;
  uint4 rk0, rk1, rk2, rv0, rv1;
  rk2 = make_uint4(0, 0, 0, 0);
  auto tileidx = [&](int i) { return (MODE == 1) ? (i < 4 ? i : tlo + i - 4) : i; };
  const int kr0 = tid / NKC, kc0 = tid - kr0 * NKC;
  const int kr1 = (tid + NT) / NKC, kc1 = (tid + NT) - kr1 * NKC;
  const int kr2 = (tid + 2 * NT) / NKC, kc2 = (tid + 2 * NT) - kr2 * NKC;
  const int vr0 = tid >> 3, vc0 = tid & 7, vr1 = (tid + NT) >> 3;
#define ATT_GLOAD(I)                                                                   \
  {                                                                                    \
    int kt_ = tileidx(I);                                                              \
    rk0 = *(const uint4*)(Kp + (size_t)(kt_ * 64 + kr0) * DQ + kc0 * 8);               \
    rk1 = *(const uint4*)(Kp + (size_t)(kt_ * 64 + kr1) * DQ + kc1 * 8);               \
    if (KCH == 3) rk2 = *(const uint4*)(Kp + (size_t)(kt_ * 64 + kr2) * DQ + kc2 * 8); \
    rv0 = *(const uint4*)(VTp + (size_t)vr0 * NKEY + kt_ * 64 + vc0 * 8);              \
    rv1 = *(const uint4*)(VTp + (size_t)vr1 * NKEY + kt_ * 64 + vc0 * 8);              \
  }
#define ATT_LSTORE(B)                                                        \
  {                                                                          \
    *(uint4*)(sK + (B) * KBYTES + kr0 * KSTR + kc0 * 16) = rk0;              \
    *(uint4*)(sK + (B) * KBYTES + kr1 * KSTR + kc1 * 16) = rk1;              \
    if (KCH == 3) *(uint4*)(sK + (B) * KBYTES + kr2 * KSTR + kc2 * 16) = rk2; \
    *(uint4*)(sV + (B) * VBYTES + vr0 * VSTR + vc0 * 16) = rv0;              \
    *(uint4*)(sV + (B) * VBYTES + vr1 * VSTR + vc0 * 16) = rv1;              \
  }
  __syncthreads();
  ATT_GLOAD(0);
  ATT_LSTORE(0);
  __syncthreads();
  for (int it = 0; it < ntile; ++it) {
    const int buf = it & 1;
    if (it + 1 < ntile) ATT_GLOAD(it + 1);
    const char* kb = sK + buf * KBYTES;
    const char* vb = sV + buf * VBYTES;
    f32x16 sacc[2];
    {
      bf16x8 kf[2][NS];
#pragma unroll
      for (int kt2 = 0; kt2 < 2; ++kt2)
#pragma unroll
        for (int s = 0; s < NS; ++s) kf[kt2][s] = *(const bf16x8*)(kb + (kt2 * 32 + r) * KSTR + (16 * s + 8 * h) * 2);
      __builtin_amdgcn_sched_barrier(0);
#pragma unroll
      for (int kt2 = 0; kt2 < 2; ++kt2) {
#pragma unroll
        for (int i = 0; i < 16; ++i) sacc[kt2][i] = -m;
#pragma unroll
        for (int s = 0; s < NS; ++s) sacc[kt2] = __builtin_amdgcn_mfma_f32_32x32x16_bf16(kf[kt2][s], qf[s], sacc[kt2], 0, 0, 0);
      }
    }
    uint2 vlo[2][2][2], vhi[2][2][2];
#pragma unroll
    for (int kt2 = 0; kt2 < 2; ++kt2)
#pragma unroll
      for (int s2 = 0; s2 < 2; ++s2)
#pragma unroll
        for (int dvt = 0; dvt < 2; ++dvt) {
          const char* vp = vb + (dvt * 32 + r) * VSTR + (kt2 * 32 + 16 * s2 + 4 * h) * 2;
          vlo[kt2][s2][dvt] = *(const uint2*)(vp);
          vhi[kt2][s2][dvt] = *(const uint2*)(vp + 16);
        }
    __builtin_amdgcn_sched_barrier(0);
    if (MODE == 1) {
      int kt = tileidx(it);
      int dbase = kt * 64 + 4 * h - 256 - (qpos0 + r);
      bool lat = kt >= 4;
#pragma unroll
      for (int kt2 = 0; kt2 < 2; ++kt2)
#pragma unroll
        for (int i = 0; i < 16; ++i) {
          int d = dbase + kt2 * 32 + (i & 3) + 8 * (i >> 2);
          bool bad = lat && (d > 128 || d < -128);
          sacc[kt2][i] = bad ? -1e30f : sacc[kt2][i];
        }
    }
    float mx = sacc[0][0];
#pragma unroll
    for (int i = 1; i < 16; ++i) mx = fmaxf(mx, sacc[0][i]);
#pragma unroll
    for (int i = 0; i < 16; ++i) mx = fmaxf(mx, sacc[1][i]);
    mx = fmaxf(mx, __shfl_xor(mx, 32));
    if (__any(mx > 8.f)) {
      float delta = fmaxf(mx, 0.f);
      float alpha = __builtin_amdgcn_exp2f(-delta);
      m += delta;
      l *= alpha;
#pragma unroll
      for (int i = 0; i < 16; ++i) { oacc[0][i] *= alpha; oacc[1][i] *= alpha; sacc[0][i] -= delta; sacc[1][i] -= delta; }
    }
    float rs = 0.f;
#pragma unroll
    for (int kt2 = 0; kt2 < 2; ++kt2)
#pragma unroll
      for (int i = 0; i < 16; ++i) { float pv = __builtin_amdgcn_exp2f(sacc[kt2][i]); sacc[kt2][i] = pv; rs += pv; }
    l += rs;
#pragma unroll
    for (int kt2 = 0; kt2 < 2; ++kt2)
#pragma unroll
      for (int s2 = 0; s2 < 2; ++s2) {
        uint4 pk;
        pk.x = pack2(sacc[kt2][8 * s2 + 0], sacc[kt2][8 * s2 + 1]);
        pk.y = pack2(sacc[kt2][8 * s2 + 2], sacc[kt2][8 * s2 + 3]);
        pk.z = pack2(sacc[kt2][8 * s2 + 4], sacc[kt2][8 * s2 + 5]);
        pk.w = pack2(sacc[kt2][8 * s2 + 6], sacc[kt2][8 * s2 + 7]);
        bf16x8 pf = __builtin_bit_cast(bf16x8, pk);
#pragma unroll
        for (int dvt = 0; dvt < 2; ++dvt) {
          uint2 lo = vlo[kt2][s2][dvt], hi = vhi[kt2][s2][dvt];
          uint4 vv = make_uint4(lo.x, lo.y, hi.x, hi.y);
          bf16x8 vf = __builtin_bit_cast(bf16x8, vv);
          oacc[dvt] = __builtin_amdgcn_mfma_f32_32x32x16_bf16(vf, pf, oacc[dvt], 0, 0, 0);
        }
      }
    if (it + 1 < ntile) ATT_LSTORE(buf ^ 1);
    __syncthreads();
  }
#undef ATT_GLOAD
#undef ATT_LSTORE
  float lt = l + __shfl_xor(l, 32);
  float il = 1.f / lt;
  u16* orow = Obase + (size_t)(orow0 + r) * 1024;
#pragma unroll
  for (int dvt = 0; dvt < 2; ++dvt)
#pragma unroll
    for (int g = 0; g < 4; ++g) {
      uint2 o;
      o.x = pack2(oacc[dvt][4 * g] * il, oacc[dvt][4 * g + 1] * il);
      o.y = pack2(oacc[dvt][4 * g + 2] * il, oacc[dvt][4 * g + 3] * il);
      *(uint2*)(orow + dvt * 32 + 8 * g + 4 * h) = o;
    }
}

DI void prep1_job(const P& p, int job, char* smem) {
  const int tid = TID(), lane = tid & 63, wave = tid >> 6;
  const u16* Z = (const u16*)(p.ws + OFF_Z);
  u16* Qd = (u16*)(p.ws + OFF_QD); u16* Kd = (u16*)(p.ws + OFF_KD); u16* VdT = (u16*)(p.ws + OFF_VDT);
  float* U = (float*)(p.ws + OFF_U); u16* X0 = (u16*)(p.ws + OFF_X0);
  const float* rope = (const float*)(p.ws + OFF_ROPE);
  u16* vt = (u16*)smem;
  float* ut = (float*)(smem + 18432);
  int r0 = job * 64;
  bool isctx = r0 >= R_LAT;
  int b, pos0;
  if (!isctx) { b = r0 >> 12; pos0 = r0 & 4095; } else { b = (r0 - R_LAT) >> 8; pos0 = (r0 - R_LAT) & 255; }
  int kidx0 = isctx ? pos0 : 256 + pos0;
  __syncthreads();
  for (int rr = 0; rr < 16; ++rr) {
    int tl = wave * 16 + rr;
    int r = r0 + tl, pos = pos0 + tl, kidx = kidx0 + tl;
    int prow = pos >> 6, pcol = pos & 63;
    const u16* zr = Z + (size_t)r * 2304;
    int l7 = lane & 7;
    int ti = (l7 < 4) ? (prow * 16 + l7 * 4) : (pcol * 16 + (l7 - 4) * 4);
    if (!isctx) {
      float f[8];
      unpack8(*(const uint4*)(zr + lane * 8), f);
      rope8(f, *(const float4*)(rope + ti), *(const float4*)(rope + 1024 + ti));
      const float qs = 0.125f * LOG2E;
#pragma unroll
      for (int j = 0; j < 8; ++j) f[j] *= qs;
      int head = lane >> 3;
      *(uint4*)(Qd + ((size_t)(b * 8 + head) * NKEY + kidx) * 64 + l7 * 8) = pack8(f);
    }
    if (lane < 16) {
      float f[8];
      unpack8(*(const uint4*)(zr + 2048 + lane * 8), f);
      if (!isctx) rope8(f, *(const float4*)(rope + ti), *(const float4*)(rope + 1024 + ti));
      int kvh = lane >> 3;
      *(uint4*)(Kd + ((size_t)(b * 2 + kvh) * NKEY + kidx) * 64 + l7 * 8) = pack8(f);
      uint4 q = *(const uint4*)(zr + 2176 + lane * 8);
      unsigned w[4] = {q.x, q.y, q.z, q.w};
#pragma unroll
      for (int j = 0; j < 4; ++j) {
        vt[(lane * 8 + 2 * j) * 72 + tl] = (u16)(w[j] & 0xffff);
        vt[(lane * 8 + 2 * j + 1) * 72 + tl] = (u16)(w[j] >> 16);
      }
    }
  }
  __syncthreads();
  {
    int d = tid >> 1, half = tid & 1;
    int kvh = d >> 6, dd = d & 63;
    u16* dst = VdT + ((size_t)(b * 2 + kvh) * 64 + dd) * NKEY + kidx0 + half * 32;
    const u16* srcp = vt + d * 72 + half * 32;
#pragma unroll
    for (int j = 0; j < 4; ++j) *(uint4*)(dst + j * 8) = *(const uint4*)(srcp + j * 8);
  }
  if (isctx) return;
  const float* cw = PIN(I_CCW);
  const float* cb = PIN(I_CCB);
  for (int cc0 = 0; cc0 < 512; cc0 += 128) {
    __syncthreads();
    int c = cc0 + (tid & 63) * 2;
    float wt0[3][2], wt1[3][2], wt2[3][2], wb[3][2];
#pragma unroll
    for (int part = 0; part < 3; ++part)
#pragma unroll
      for (int e = 0; e < 2; ++e) {
        int ch = part * 512 + c + e;
        wt0[part][e] = cw[ch]; wt1[part][e] = cw[1536 + ch]; wt2[part][e] = cw[3072 + ch]; wb[part][e] = cb[ch];
      }
    const int tl0 = (tid >> 6) * 16;
    const u16* zb = Z + (size_t)(r0 + tl0) * 2304 + 512 + c;
    unsigned prv[3], cur[3];
#pragma unroll
    for (int part = 0; part < 3; ++part) {
      cur[part] = *(const unsigned*)(zb + part * 512);
      prv[part] = (pos0 + tl0 > 0) ? *(const unsigned*)(zb + part * 512 - 2304) : 0u;
    }
#pragma unroll 4
    for (int rr = 0; rr < 16; ++rr) {
      int tl = tl0 + rr;
      int r = r0 + tl, pos = pos0 + tl;
      float res[3][2];
#pragma unroll
      for (int part = 0; part < 3; ++part) {
        unsigned nxt = (pos < 4095) ? *(const unsigned*)(zb + part * 512 + (size_t)(rr + 1) * 2304) : 0u;
#pragma unroll
        for (int e = 0; e < 2; ++e) {
          float xc = e ? __uint_as_float(cur[part] & 0xffff0000u) : __uint_as_float(cur[part] << 16);
          float xp = e ? __uint_as_float(prv[part] & 0xffff0000u) : __uint_as_float(prv[part] << 16);
          float xn = e ? __uint_as_float(nxt & 0xffff0000u) : __uint_as_float(nxt << 16);
          res[part][e] = xp * wt0[part][e] + xc * wt1[part][e] + xn * wt2[part][e] + wb[part][e];
        }
        prv[part] = cur[part]; cur[part] = nxt;
      }
      *(unsigned*)(X0 + (size_t)r * 512 + c) = pack2(res[0][0], res[0][1]);
      ut[((tid & 63) * 2) * 65 + tl] = res[2][0] * res[1][0];
      ut[((tid & 63) * 2 + 1) * 65 + tl] = res[2][1] * res[1][1];
    }
    __syncthreads();
    for (int i = 0; i < 32; ++i) {
      int ch = (tid >> 6) + 4 * i;
      U[((size_t)(cc0 + ch) * 8 + b) * 4096 + pos0 + (tid & 63)] = ut[ch * 65 + (tid & 63)];
    }
  }
}

DI float2 cmul(float2 a, float2 b) { return make_float2(a.x * b.x - a.y * b.y, a.x * b.y + a.y * b.x); }
DI float2 cmulc(float2 a, float2 b) { return make_float2(a.x * b.x + a.y * b.y, a.y * b.x - a.x * b.y); }
DI void fft_fwd(float2* sm, const float2* __restrict__ tw) {
  const int tid = TID();
#pragma unroll 1
  for (int m = 4096, sh = 0; m >= 2; m >>= 2, sh += 2) {
    const int hm = m >> 1;
#pragma unroll 1
    for (int hh = 0; hh < 4; ++hh) {
      float2 x0[2], x1[2], x2[2], x3[2];
#pragma unroll
      for (int i = 0; i < 2; ++i) {
        int g = tid + NT * (i + 2 * hh);
        int pp = g & (hm - 1);
        int i0 = ((g - pp) << 2) + pp;
        x0[i] = sm[i0]; x1[i] = sm[i0 + hm]; x2[i] = sm[i0 + m]; x3[i] = sm[i0 + m + hm];
      }
#pragma unroll
      for (int i = 0; i < 2; ++i) {
        int g = tid + NT * (i + 2 * hh);
        int pp = g & (hm - 1);
        int i0 = ((g - pp) << 2) + pp;
        float fr_ = (float)(pp << sh) * (1.f / 8192.f);
        float2 w1 = make_float2(__builtin_amdgcn_cosf(fr_), -__builtin_amdgcn_sinf(fr_));
        float2 w2 = make_float2(__builtin_amdgcn_cosf(2.f * fr_), -__builtin_amdgcn_sinf(2.f * fr_));
        float2 a0 = make_float2(x0[i].x + x2[i].x, x0[i].y + x2[i].y);
        float2 a2 = cmul(make_float2(x0[i].x - x2[i].x, x0[i].y - x2[i].y), w1);
        float2 a1 = make_float2(x1[i].x + x3[i].x, x1[i].y + x3[i].y);
        float2 d13 = cmul(make_float2(x1[i].x - x3[i].x, x1[i].y - x3[i].y), w1);
        float2 a3 = make_float2(d13.y, -d13.x);
        sm[i0] = make_float2(a0.x + a1.x, a0.y + a1.y);
        sm[i0 + hm] = cmul(make_float2(a0.x - a1.x, a0.y - a1.y), w2);
        sm[i0 + m] = make_float2(a2.x + a3.x, a2.y + a3.y);
        sm[i0 + m + hm] = cmul(make_float2(a2.x - a3.x, a2.y - a3.y), w2);
      }
    }
    __syncthreads();
  }
#pragma unroll 4
  for (int i = 0; i < 16; ++i) {
    int j = tid + NT * i;
    float2 a = sm[2 * j], b = sm[2 * j + 1];
    sm[2 * j] = make_float2(a.x + b.x, a.y + b.y);
    sm[2 * j + 1] = make_float2(a.x - b.x, a.y - b.y);
  }
  __syncthreads();
}
DI void fft_inv(float2* sm, const float2* __restrict__ tw) {
  const int tid = TID();
#pragma unroll 4
  for (int i = 0; i < 16; ++i) {
    int j = tid + NT * i;
    float2 a = sm[2 * j], b = sm[2 * j + 1];
    sm[2 * j] = make_float2(a.x + b.x, a.y + b.y);
    sm[2 * j + 1] = make_float2(a.x - b.x, a.y - b.y);
  }
  __syncthreads();
#pragma unroll 1
  for (int m = 4, sh = 10; m <= 4096; m <<= 2, sh -= 2) {
    const int hm = m >> 1;
#pragma unroll 1
    for (int hh = 0; hh < 4; ++hh) {
      float2 x0[2], x1[2], x2[2], x3[2];
#pragma unroll
      for (int i = 0; i < 2; ++i) {
        int g = tid + NT * (i + 2 * hh);
        int pp = g & (hm - 1);
        int i0 = ((g - pp) << 2) + pp;
        x0[i] = sm[i0]; x1[i] = sm[i0 + hm]; x2[i] = sm[i0 + m]; x3[i] = sm[i0 + m + hm];
      }
#pragma unroll
      for (int i = 0; i < 2; ++i) {
        int g = tid + NT * (i + 2 * hh);
        int pp = g & (hm - 1);
        int i0 = ((g - pp) << 2) + pp;
        float fr_ = (float)(pp << sh) * (1.f / 8192.f);
        float2 w1 = make_float2(__builtin_amdgcn_cosf(fr_), -__builtin_amdgcn_sinf(fr_));
        float2 w2 = make_float2(__builtin_amdgcn_cosf(2.f * fr_), -__builtin_amdgcn_sinf(2.f * fr_));
        float2 b1 = cmulc(x1[i], w2), b3 = cmulc(x3[i], w2);
        float2 a0 = make_float2(x0[i].x + b1.x, x0[i].y + b1.y), a1 = make_float2(x0[i].x - b1.x, x0[i].y - b1.y);
        float2 a2 = make_float2(x2[i].x + b3.x, x2[i].y + b3.y), a3 = make_float2(x2[i].x - b3.x, x2[i].y - b3.y);
        float2 c2 = cmulc(a2, w1);
        float2 t3 = cmulc(a3, w1);
        float2 c3 = make_float2(-t3.y, t3.x);
        sm[i0] = make_float2(a0.x + c2.x, a0.y + c2.y);
        sm[i0 + m] = make_float2(a0.x - c2.x, a0.y - c2.y);
        sm[i0 + hm] = make_float2(a1.x + c3.x, a1.y + c3.y);
        sm[i0 + m + hm] = make_float2(a1.x - c3.x, a1.y - c3.y);
      }
    }
    __syncthreads();
  }
}
DI void fft_job(const P& p, int c, char* smem) {
  const int tid = TID();
  float2* sm = (float2*)smem;
  const float2* tw = (const float2*)(p.ws + OFF_TW);
  const float* kf = (const float*)(p.ws + OFF_KF) + (size_t)c * 8192;
  float* U = (float*)(p.ws + OFF_U) + (size_t)c * 8 * 4096;
  float* Yc = (float*)(p.ws + OFF_Y) + (size_t)c * 8 * 4096;
  float bias = PIN(I_CBIAS)[c];
  __syncthreads();
#pragma unroll 4
  for (int i = 0; i < 32; ++i) sm[tid + NT * i] = make_float2(kf[tid + NT * i], 0.f);
  __syncthreads();
  fft_fwd(sm, tw);
  float2 kr[32];
#pragma unroll
  for (int i = 0; i < 32; ++i) { float2 v = sm[tid + NT * i]; kr[i] = make_float2(v.x * (1.f / 8192.f), v.y * (1.f / 8192.f)); }
#pragma unroll 1
  for (int pr = 0; pr < 4; ++pr) {
    float* u0 = U + (size_t)(2 * pr) * 4096;
    float* u1 = u0 + 4096;
    __syncthreads();
#pragma unroll 4
    for (int i = 0; i < 16; ++i) {
      int idx = tid + NT * i;
      sm[idx] = make_float2(u0[idx], u1[idx]);
      sm[idx + 4096] = make_float2(0.f, 0.f);
    }
    __syncthreads();
    fft_fwd(sm, tw);
#pragma unroll
    for (int i = 0; i < 32; ++i) sm[tid + NT * i] = cmul(sm[tid + NT * i], kr[i]);
    __syncthreads();
    fft_inv(sm, tw);
#pragma unroll 4
    for (int i = 0; i < 16; ++i) {
      int idx = tid + NT * i;
      float2 y = sm[idx];
      float a0 = u0[idx], a1 = u1[idx];
      Yc[(size_t)(2 * pr) * 4096 + idx] = y.x + bias * a0;
      Yc[(size_t)(2 * pr + 1) * 4096 + idx] = y.y + bias * a1;
    }
  }
}

DI void gate_job(const P& p, int job, char* smem) {
  const int tid = TID();
  float* yt = (float*)smem;
  const float* Y = (const float*)(p.ws + OFF_Y);
  const u16* X0 = (const u16*)(p.ws + OFF_X0);
  u16* O = (u16*)(p.ws + OFF_H);
  int tile = job >> 2, cc0 = (job & 3) * 128;
  int r0 = tile * 64, b = r0 >> 12, pos0 = r0 & 4095;
  __syncthreads();
  for (int i = 0; i < 32; ++i) {
    int ch = (tid >> 6) + 4 * i;
    yt[ch * 65 + (tid & 63)] = Y[((size_t)(cc0 + ch) * 8 + b) * 4096 + pos0 + (tid & 63)];
  }
  __syncthreads();
#pragma unroll 4
  for (int i = 0; i < 16; ++i) {
    int tl = (tid >> 6) + 4 * i, ch = (tid & 63) * 2;
    unsigned xx = *(const unsigned*)(X0 + (size_t)(r0 + tl) * 512 + cc0 + ch);
    float a0 = __uint_as_float(xx << 16) * yt[ch * 65 + tl];
    float a1 = __uint_as_float(xx & 0xffff0000u) * yt[(ch + 1) * 65 + tl];
    *(unsigned*)(O + (size_t)(r0 + tl) * 1024 + 512 + cc0 + ch) = pack2(a0, a1);
  }
}

DI void gemm_store_phase(const u16* ZR, const u16* A, int lda, int M, const u16* W, int K, int ntn, int N, u16* OUT, int ldo, char* smem) {
  int ntm = M / 256;
  JobIter it = xcd_jobs(ntm * ntn);
  for (int job = it.j; job < it.end; job += it.step) {
    int mt, nt; gemm_decode(job, ntn, mt, nt);
    int m0 = mt * 256, n0 = nt * 256;
    gemm_tile<1>(ZR, A, lda, m0, 0, M, W, K, n0, n0 + 64, n0 + 128, n0 + 192, K, smem, [&](int tl, int fl, f32x4 v) {
      int n = n0 + fl;
      if (n < N) {
        uint2 o; o.x = pack2(v[0], v[1]); o.y = pack2(v[2], v[3]);
        *(uint2*)(OUT + (size_t)(m0 + tl) * ldo + n) = o;
      }
    }, [](int) {});
  }
}
DI void gemm_resid_phase(const u16* ZR, const u16* A, int lda, int M, const u16* W, int K, const float* xin_l,
                         float* xo_l, float* part, const float* mods, int goff, char* smem) {
  JobIter it = xcd_jobs((R_LAT / 256) * 4);
  for (int job = it.j; job < it.end; job += it.step) {
    int mt, nt; gemm_decode(job, 4, mt, nt);
    int m0 = mt * 256, n0 = nt * 256;
    gemm_tile<1>(ZR, A, lda, m0, 0, M, W, K, n0, n0 + 64, n0 + 128, n0 + 192, K, smem, [&](int tl, int fl, f32x4 v) {
      int r = m0 + tl, n = n0 + fl;
      float4 x = *(const float4*)(xin_l + (size_t)r * 1024 + n);
      float4 g = *(const float4*)(mods + (size_t)(r >> 12) * 6144 + goff + n);
      x.x += g.x * v[0]; x.y += g.y * v[1]; x.z += g.z * v[2]; x.w += g.w * v[3];
      *(float4*)(xo_l + (size_t)r * 1024 + n) = x;
    }, [](int) {});
  }
  if (M > R_LAT) {
    const int Ks = K >> 2;
    for (int j = blockIdx.x; j < 128; j += gridDim.x) {
      int mt = (R_LAT / 256) + (j >> 4), nt = (j >> 2) & 3, ks = j & 3;
      int m0 = mt * 256, n0 = nt * 256, k0 = ks * Ks;
      gemm_tile<1>(ZR, A + k0, lda, m0, 0, M, W + k0, K, n0, n0 + 64, n0 + 128, n0 + 192, Ks, smem, [&](int tl, int fl, f32x4 v) {
        int r = m0 + tl - R_LAT, n = n0 + fl;
        *(float4*)(part + ((size_t)ks * 2048 + r) * 1024 + n) = make_float4(v[0], v[1], v[2], v[3]);
      }, [](int) {});
    }
  }
}
DI void ffn_up_phase(const P& p, int layer, int M, char* smem) {
  const u16* H = (const u16*)(p.ws + OFF_H);
  const u16* W = (const u16*)(p.ws + OFF_WUP) + (size_t)layer * 5632 * 1024;
  u16* ACT = (u16*)(p.ws + OFF_ACT);
  const u16* ZR = (const u16*)(p.ws + OFF_ZERO);
  const float* cw = PIN(I_FCW) + (size_t)layer * 3 * 5632;
  const float* cb = PIN(I_FCB) + (size_t)layer * 5632;
  const int tid = PTID();
  int nmt = 8 * 16 + ((M > R_LAT) ? 8 : 0);
  float* EDGE = (float*)(p.ws + OFF_EDGE);
  float* ct = (float*)smem;
  JobIter it = xcd_jobs(nmt * 22);
  for (int job = it.j; job < it.end; job += it.step) {
    int mt, nt; gemm_decode(job, 22, mt, nt);
    int seq0, L, tj;
    int ntj;
    if (mt < 128) { int s_ = mt >> 4; tj = mt & 15; seq0 = s_ * 4096; L = 4096; ntj = 16; }
    else { int s_ = mt - 128; tj = 0; seq0 = R_LAT + s_ * 256; L = 256; ntj = 1; }
    const bool first_t = (tj == 0), last_t = (tj == ntj - 1);
    int tstart = tj * 256;
    int arow0 = seq0 + tstart;
    int n0 = nt * 128;
    gemm_tile<2>(ZR, H, 1024, arow0, seq0, seq0 + L, W, 1024, n0, 2816 + n0, n0 + 64, 2816 + n0 + 64, 1024, smem,
      [&](int tl, int fl, f32x4 v) {
#pragma unroll
        for (int j = 0; j < 4; ++j) ct[((fl & 127) + j) * 257 + tl] = v[j];
      },
      [&](int ph) {
        __syncthreads();
        int j = tid & 63;
        int gc = n0 + ph * 64 + j;
        float wg0 = cw[gc], wg1 = cw[5632 + gc], wg2 = cw[2 * 5632 + gc], bg = cb[gc];
        float wv0 = cw[2816 + gc], wv1 = cw[5632 + 2816 + gc], wv2 = cw[2 * 5632 + 2816 + gc], bv = cb[2816 + gc];
        const float* cg_ = ct + j * 257;
        const float* cv_ = ct + (64 + j) * 257;
        const int i0 = 32 * (tid >> 6);
        if (mt < 128) {
          float* eg = EDGE + (size_t)mt * 4 * 5632 + gc;
          if ((tid >> 6) == 0) { eg[0] = cg_[0]; eg[5632] = cg_[1]; eg[2816] = cv_[0]; eg[5632 + 2816] = cv_[1]; }
          if ((tid >> 6) == 7) { eg[2 * 5632] = cg_[254]; eg[3 * 5632] = cg_[255]; eg[2 * 5632 + 2816] = cv_[254]; eg[3 * 5632 + 2816] = cv_[255]; }
        }
        float gp = (i0 > 0) ? cg_[i0 - 1] : 0.f, gc_ = cg_[i0], vp = (i0 > 0) ? cv_[i0 - 1] : 0.f, vc = cv_[i0];
        u16* outp = ACT + (size_t)(seq0 + tstart + i0) * 2816 + gc;
#pragma unroll 4
        for (int it2 = 0; it2 < 32; ++it2) {
          int i = i0 + it2;
          float gn = (i + 1 <= 255) ? cg_[i + 1] : 0.f, vn = (i + 1 <= 255) ? cv_[i + 1] : 0.f;
          if ((i >= 1 || first_t) && (i <= 254 || last_t)) {
            float g = wg0 * gp + wg1 * gc_ + wg2 * gn + bg;
            float vv = wv0 * vp + wv1 * vc + wv2 * vn + bv;
            float a = g * __builtin_amdgcn_rcpf(1.f + __expf(-g)) * vv;
            outp[(size_t)it2 * 2816] = (u16)(pack2(a, 0.f) & 0xffffu);
          }
          gp = gc_; gc_ = gn; vp = vc; vc = vn;
        }
        __syncthreads();
      });
  }
}

DI void ffn_fix_phase(const P& p, int layer) {
  u16* ACT = (u16*)(p.ws + OFF_ACT);
  const float* EDGE = (const float*)(p.ws + OFF_EDGE);
  const float* cw = PIN(I_FCW) + (size_t)layer * 3 * 5632;
  const float* cb = PIN(I_FCB) + (size_t)layer * 5632;
  const int total = 8 * 15 * 2816;
  for (int w = VB() * NT + TID(); w < total; w += NVB() * NT) {
    int bidx = w / 2816, col = w - bidx * 2816;
    int s_ = bidx / 15, tj = bidx - s_ * 15;
    int mt = s_ * 16 + tj;
    const float* Ea = EDGE + (size_t)mt * 4 * 5632;
    const float* Eb = Ea + 4 * 5632;
    float g254 = Ea[2 * 5632 + col], g255 = Ea[3 * 5632 + col], g0 = Eb[col], g1 = Eb[5632 + col];
    float v254 = Ea[2 * 5632 + 2816 + col], v255 = Ea[3 * 5632 + 2816 + col], v0 = Eb[2816 + col], v1 = Eb[5632 + 2816 + col];
    float wg0 = cw[col], wg1 = cw[5632 + col], wg2 = cw[2 * 5632 + col], bg = cb[col];
    float wv0 = cw[2816 + col], wv1 = cw[5632 + 2816 + col], wv2 = cw[2 * 5632 + 2816 + col], bv = cb[2816 + col];
    size_t row = (size_t)s_ * 4096 + tj * 256 + 255;
    {
      float g = wg0 * g254 + wg1 * g255 + wg2 * g0 + bg;
      float vv = wv0 * v254 + wv1 * v255 + wv2 * v0 + bv;
      ACT[row * 2816 + col] = f2bf(g * __builtin_amdgcn_rcpf(1.f + __expf(-g)) * vv);
    }
    {
      float g = wg0 * g255 + wg1 * g0 + wg2 * g1 + bg;
      float vv = wv0 * v255 + wv1 * v0 + wv2 * v1 + bv;
      ACT[(row + 1) * 2816 + col] = f2bf(g * __builtin_amdgcn_rcpf(1.f + __expf(-g)) * vv);
    }
  }
}

__global__ void __launch_bounds__(PT, 2) mega(P p) {
  extern __shared__ __attribute__((aligned(16))) char smem[];
  char* vsm = smem + VHALF() * VLDS;
  cg::grid_group grid = cg::this_grid();
  __shared__ uint4 xb_words;
  if (threadIdx.x == 0) xb_words = make_uint4(0u, 0u, 0u, 0u);
  __syncthreads();
  XcdBarrier xb = xcd_barrier_post((unsigned*)(p.ws + OFF_BAR), (volatile LAS unsigned*)&xb_words);
  const int tid = TID(), wave = tid >> 6;
  char* ws = p.ws;
  float* mods = (float*)(ws + OFF_MODS);
  float* ctxx = (float*)(ws + OFF_CTXX);
  u16* H = (u16*)(ws + OFF_H);
  u16* Z = (u16*)(ws + OFF_Z);
  const u16* ZR = (const u16*)(ws + OFF_ZERO);

  if (blockIdx.x == 0 && threadIdx.x < 35) ((const float**)(ws + OFF_TAB))[threadIdx.x] = p.in[threadIdx.x];
  {
    constexpr int J_EVIN = 192, J_EVOUT = 128, J_UQ = 36, J_UKV = 32, J_ODIN = 288, J_ODOUT = 128, J_UP = 704, J_DOWN = 352;
    constexpr int J_MODS = 384, J_TAB = 2, J_FILT = 256;
    constexpr int T0 = J_MODS, T1 = T0 + J_TAB, T2 = T1 + J_FILT, T3 = T2 + J_EVIN, T4 = T3 + J_EVOUT, T5 = T4 + J_UQ, T6 = T5 + J_UKV,
                  T7 = T6 + J_ODIN, T8 = T7 + J_ODOUT, T9 = T8 + 2 * J_UP, T10 = T9 + 2 * J_DOWN;
    JobIter it0 = vjobs_plain(T10);
    VJOB_LOOP(it0, job) {
      float* smf = (float*)vsm;
      if (job < T0) mods_job(p, job, smf);
      else if (job < T1) tables_job(p);
      else if (job < T2) filter_job(p, job - T1, smf);
      else if (job < T3) wconv_tile(PIN0(I_EVIN), 1024, 1440, (u16*)(ws + OFF_WEVIN), job - T2, smf);
      else if (job < T4) wconv_tile(PIN0(I_EVOUT), 1024, 1024, (u16*)(ws + OFF_WEVOUT), job - T3, smf);
      else if (job < T5) wconv_tile(PIN0(I_WUQ), 384, 768, (u16*)(ws + OFF_WUQ), job - T4, smf);
      else if (job < T6) wconv_tile(PIN0(I_WUKV), 256, 1024, (u16*)(ws + OFF_WUKV), job - T5, smf);
      else if (job < T7) wconv_tile(PIN0(I_ODIN), 1024, 2304, (u16*)(ws + OFF_WODIN), job - T6, smf);
      else if (job < T8) wconv_tile(PIN0(I_ODOUT), 1024, 1024, (u16*)(ws + OFF_WODOUT), job - T7, smf);
      else if (job < T9) {
        int q = job - T8, l = q / J_UP;
        wconv_tile(PIN0(I_FUP) + (size_t)l * 1024 * 5632, 1024, 5632, (u16*)(ws + OFF_WUP) + (size_t)l * 5632 * 1024, q - l * J_UP, smf);
      } else {
        int q = job - T9, l = q / J_DOWN;
        wconv_tile(PIN0(I_FDOWN) + (size_t)l * 2816 * 1024, 2816, 1024, (u16*)(ws + OFF_WDOWN) + (size_t)l * 1024 * 2816, q - l * J_DOWN, smf);
      }
    }
  }
  if (p.use_cg_sync) grid.sync();
  xcd_barrier(xb);

  normmod_phase(PIN(I_X), PIN(I_CTX), PIN(I_NMIX), mods, 0, 1024, H);
  xcd_barrier(xb);
  gemm_store_phase(ZR, H, 1024, R_ALL, (const u16*)(ws + OFF_WEVIN), 1024, 6, 1440, Z, 1440, smem);
  xcd_barrier(xb);
  { JobIter itp = vjobs_plain(R_ALL / 32); VJOB_LOOP(itp, job) prep0_job(p, job, vsm); }
  xcd_barrier(xb);
  {
    const u16* CQ = (const u16*)(ws + OFF_CQ);
    const u16* CKV = (const u16*)(ws + OFF_CKV);
    u16* Qb = (u16*)(ws + OFF_QB); u16* Kb = (u16*)(ws + OFF_KB); u16* VbT = (u16*)(ws + OFF_VBT);
    const float* rope = (const float*)(ws + OFF_ROPE);
    const int ntm = R_ALL / 256;
    JobIter it = xcd_jobs(ntm * 7);
    for (int job = it.j; job < it.end; job += it.step) {
      int mt, nt; gemm_decode(job, 7, mt, nt);
      int m0 = mt * 256;
      if (nt < 3) {
        int n0 = nt * 256;
        gemm_tile<1>(ZR, CQ, 384, m0, 0, R_ALL, (const u16*)(ws + OFF_WUQ), 384, n0, n0 + 64, n0 + 128, n0 + 192, 384, smem, [&](int tl, int fl, f32x4 v) {
          int r = m0 + tl, f = n0 + fl;
          int head = f / 96, d = f - head * 96;
          int b, pos, kidx;
          bool isctx = r >= R_LAT;
          if (!isctx) { b = r >> 12; pos = r & 4095; kidx = 256 + pos; } else { b = (r - R_LAT) >> 8; pos = (r - R_LAT) & 255; kidx = pos; }
          float x0 = v[0], x1 = v[1], x2 = v[2], x3 = v[3];
          if (d >= 64 && !isctx) {
            int pi = (d - 64) >> 1;
            int prow = pos >> 6, pcol = pos & 63;
            int ti = (pi < 8) ? (prow * 8 + pi) : (pcol * 8 + pi - 8);
            float c0 = rope[2048 + ti], s0 = rope[2560 + ti], c1 = rope[2048 + ti + 1], s1 = rope[2560 + ti + 1];
            float a = x0, bb = x1;
            x0 = a * c0 - bb * s0; x1 = a * s0 + bb * c0;
            a = x2; bb = x3;
            x2 = a * c1 - bb * s1; x3 = a * s1 + bb * c1;
          }
          const float qs = 0.10206207261596575f * LOG2E;
          uint2 o; o.x = pack2(x0 * qs, x1 * qs); o.y = pack2(x2 * qs, x3 * qs);
          *(uint2*)(Qb + ((size_t)(b * 8 + head) * NKEY + kidx) * 96 + d) = o;
        }, [](int) {});
      } else {
        int n0 = (nt - 3) * 256;
        gemm_tile<1>(ZR, CKV, 256, m0, 0, R_ALL, (const u16*)(ws + OFF_WUKV), 256, n0, n0 + 64, n0 + 128, n0 + 192, 256, smem, [&](int tl, int fl, f32x4 v) {
          int r = m0 + tl, f = n0 + fl;
          int head = f >> 7, d = f & 127;
          int b, kidx;
          if (r < R_LAT) { b = r >> 12; kidx = 256 + (r & 4095); } else { b = (r - R_LAT) >> 8; kidx = (r - R_LAT) & 255; }
          if (d < 64) {
            uint2 o; o.x = pack2(v[0], v[1]); o.y = pack2(v[2], v[3]);
            *(uint2*)(Kb + ((size_t)(b * 8 + head) * NKEY + kidx) * 96 + d) = o;
          } else {
            u16* dst = VbT + ((size_t)(b * 8 + head) * 64 + (d - 64)) * NKEY + kidx;
            dst[0] = f2bf(v[0]); dst[NKEY] = f2bf(v[1]); dst[2 * NKEY] = f2bf(v[2]); dst[3 * NKEY] = f2bf(v[3]);
          }
        }, [](int) {});
      }
    }
  }
  xcd_barrier(xb);
  {
    const u16* Qa = (const u16*)(ws + OFF_QA); const u16* Ka = (const u16*)(ws + OFF_KA); const u16* VaT = (const u16*)(ws + OFF_VAT);
    const u16* Qb = (const u16*)(ws + OFF_QB); const u16* Kb = (const u16*)(ws + OFF_KB); const u16* VbT = (const u16*)(ws + OFF_VBT);
    u16* O = H;
    constexpr int JA = 8 * 2 * 136, JB = 8 * 8 * 34;
    JobIter itb = vjobs_xcd(JB);
#pragma unroll 1
    VJOB_LOOP(itb, jb) {
      int xq = jb / 272, cq = jb - xq * 272, bh, qg;
      if (cq < 256) { bh = 8 * xq + (cq >> 5); qg = 2 + (cq & 31); } else { int c2 = cq - 256; bh = 8 * xq + (c2 >> 1); qg = c2 & 1; }
      int b = bh >> 3, head = bh & 7;
      int q0 = qg * 128 + wave * 32;
      int ntile = (qg < 2) ? 4 : 68;
      int orow0 = (q0 < 256) ? (R_LAT + b * 256 + q0) : (b * 4096 + q0 - 256);
      attn_job<96, 0>(Qb + ((size_t)bh * NKEY + q0) * 96, Kb + (size_t)bh * NKEY * 96, VbT + (size_t)bh * 64 * NKEY, ntile, 0, 0, 0.f,
                      O + 512 + head * 64, orow0, vsm);
    }
    JobIter ita = vjobs_xcd(JA);
#pragma unroll 1
    VJOB_LOOP(ita, ja) {
      int xq = ja / 272, cq = ja - xq * 272, bk, qb;
      if (cq < 256) { bk = 2 * xq + (cq >> 7); qb = 8 + (cq & 127); } else { int c2 = cq - 256; bk = 2 * xq + (c2 >> 3); qb = c2 & 7; }
      int b = bk >> 1, kvh = bk & 1;
      int head = kvh * 4 + wave;
      int q0 = qb * 32;
      int ntile = (qb < 8) ? 4 : 68;
      int orow0 = (q0 < 256) ? (R_LAT + b * 256 + q0) : (b * 4096 + q0 - 256);
      attn_job<64, 0>(Qa + ((size_t)(b * 8 + head) * NKEY + q0) * 64, Ka + (size_t)bk * NKEY * 64, VaT + (size_t)bk * 64 * NKEY, ntile, 0, 0,
                      0.f, O + head * 64, orow0, vsm);
    }
  }
  xcd_barrier(xb);
  gemm_resid_phase(ZR, H, 1024, R_ALL, (const u16*)(ws + OFF_WEVOUT), 1024, PIN(I_X), p.out, (float*)(ws + OFF_Y), mods, 2048, smem);
  xcd_barrier(xb);
  normmod_phase(p.out, PIN(I_CTX), PIN(I_NFFN), mods, 3072, 4096, H, (const float*)(ws + OFF_Y), 2048, ctxx);
  xcd_barrier(xb);
  ffn_up_phase(p, 0, R_ALL, smem);
  xcd_barrier(xb);
  ffn_fix_phase(p, 0);
  xcd_barrier(xb);
  gemm_resid_phase(ZR, (const u16*)(ws + OFF_ACT), 2816, R_ALL, (const u16*)(ws + OFF_WDOWN), 2816, p.out, p.out, (float*)(ws + OFF_Y), mods, 5120, smem);
  xcd_barrier(xb);

  const float* mods1 = mods + 9 * 6144;
  normmod_phase(p.out, ctxx, PIN(I_NMIX) + 1024, mods1, 0, 1024, H, (const float*)(ws + OFF_Y), 5120 - 9 * 6144, ctxx);
  xcd_barrier(xb);
  gemm_store_phase(ZR, H, 1024, R_ALL, (const u16*)(ws + OFF_WODIN), 1024, 9, 2304, Z, 2304, smem);
  xcd_barrier(xb);
  { JobIter itp = vjobs_plain(R_ALL / 64); VJOB_LOOP(itp, job) prep1_job(p, job, vsm); }
  xcd_barrier(xb);
  {
    const u16* Qd = (const u16*)(ws + OFF_QD); const u16* Kd = (const u16*)(ws + OFF_KD); const u16* VdT = (const u16*)(ws + OFF_VDT);
    u16* O = H;
    constexpr int JF = 512, JD = 8 * 2 * 128;
    JobIter itm = vjobs_plain(JF + JD);
    VJOB_LOOP(itm, job) {
      if (job < JF) fft_job(p, job, vsm);
      else {
        int jd = job - JF;
        int bk = jd >> 7, qb = jd & 127;
        int b = bk >> 1, kvh = bk & 1;
        int head = kvh * 4 + wave;
        int t0 = qb * 32;
        int klo = 256 + (t0 - 128 > 0 ? t0 - 128 : 0), khi = 256 + (t0 + 159 < 4095 ? t0 + 159 : 4095);
        int tlo = klo >> 6, thi = khi >> 6;
        int ntile = 4 + (thi - tlo + 1);
        float sink = PIN(I_SINK)[head] * LOG2E;
        attn_job<64, 1>(Qd + ((size_t)(b * 8 + head) * NKEY + 256 + t0) * 64, Kd + (size_t)bk * NKEY * 64, VdT + (size_t)bk * 64 * NKEY, ntile,
                        tlo, t0, sink, O + head * 64, b * 4096 + t0, vsm);
      }
    }
  }
  xcd_barrier(xb);
  { JobIter itp = vjobs_plain((R_LAT / 64) * 4); VJOB_LOOP(itp, job) gate_job(p, job, vsm); }
  xcd_barrier(xb);
  gemm_resid_phase(ZR, H, 1024, R_LAT, (const u16*)(ws + OFF_WODOUT), 1024, p.out, p.out, nullptr, mods1, 2048, smem);
  xcd_barrier(xb);
  normmod_phase(p.out, ctxx, PIN(I_NFFN) + 1024, mods1, 3072, 4096, H);
  xcd_barrier(xb);
  ffn_up_phase(p, 1, R_LAT, smem);
  xcd_barrier(xb);
  ffn_fix_phase(p, 1);
  xcd_barrier(xb);
  gemm_resid_phase(ZR, (const u16*)(ws + OFF_ACT), 2816, R_LAT, (const u16*)(ws + OFF_WDOWN) + (size_t)1024 * 2816, 2816, p.out, p.out, nullptr,
                   mods1, 5120, smem);
  xcd_barrier(xb);
  {
    const int lane = tid & 63;
    const float* gain = PIN(I_FNORM);
    for (int r = VB() * 4 + wave; r < R_LAT; r += NVB() * 4) {
      float* xr = p.out + (size_t)r * 1024;
      float4 v[4];
      float ss = 0.f;
#pragma unroll
      for (int i = 0; i < 4; ++i) {
        v[i] = *(const float4*)(xr + lane * 4 + 256 * i);
        ss += v[i].x * v[i].x + v[i].y * v[i].y + v[i].z * v[i].z + v[i].w * v[i].w;
      }
      ss = wave_sum(ss);
      float inv = rsqrtf(ss * (1.f / 1024.f) + EPS);
#pragma unroll
      for (int i = 0; i < 4; ++i) {
        float4 g = *(const float4*)(gain + lane * 4 + 256 * i);
        float4 o = make_float4(v[i].x * inv * g.x, v[i].y * inv * g.y, v[i].z * inv * g.z, v[i].w * inv * g.w);
        *(float4*)(xr + lane * 4 + 256 * i) = o;
      }
    }
  }
}

extern "C" void kernel_launch(void* const* d_in, const int* in_sizes, int n_in, void* d_out, int out_size, void* d_ws, size_t ws_size,
                              hipStream_t stream) {
  static int grid_blocks = 0;
  if (!grid_blocks) {
    int dev = 0, cus = 0, per_cu = 0;
    hipGetDevice(&dev);
    hipDeviceGetAttribute(&cus, hipDeviceAttributeMultiprocessorCount, dev);
    hipFuncSetAttribute((const void*)mega, hipFuncAttributeMaxDynamicSharedMemorySize, LDS_BYTES);
    hipOccupancyMaxActiveBlocksPerMultiprocessor(&per_cu, mega, PT, LDS_BYTES);
    if (per_cu > 1) per_cu = 1;
    if (per_cu < 1) per_cu = 1;
    grid_blocks = cus * per_cu;
  }
  P p{};
  for (int i = 0; i < 35; ++i) p.in[i] = (const float*)d_in[i];
  p.out = (float*)d_out;
  p.ws = (char*)d_ws;
  (void)hipMemsetAsync((char*)d_ws + OFF_BAR, 0, XCD_BAR_WORDS * 4 + 8192, stream);
  void* args[] = {&p};
  hipError_t e = hipLaunchCooperativeKernel((void*)mega, dim3(grid_blocks), dim3(PT), args, LDS_BYTES, stream);
  if (e != hipSuccess) fprintf(stderr, "cooperative launch failed: %s (grid %d)\n", hipGetErrorString(e), grid_blocks);
}
```
